# Optimizing an MI355X kernel written in HIP

```python
import jax
import jax.numpy as jnp
from jax import lax
import numpy as np

D_MODEL = 1024
BATCH = 8
SEQ = 4096
DEPTH = 2

CTX_LEN = 256
GRID_W = 64
ML_HEADS = 4
ML_DQK = 64
ML_DV = 128
ML_CHUNK = 64
MLA_HEADS = 8
MLA_Q_RANK = 384
MLA_KV_RANK = 256
MLA_NOPE = 64
MLA_ROPE = 32
MLA_V = 64
NA_HEADS = 8
NA_DH = 64
NA_WIN_R = 8
NA_WIN_C = 16
D_FF = 4 * D_MODEL
N_BRANCH = 3
ROPE_THETA = 10000.0
Q_BLOCK = 128
EPS = 1e-6
NEG_INF = -1e30
IN_SIZES = (
    ML_HEADS * ML_DQK, ML_HEADS * ML_DQK, ML_HEADS * ML_DV, ML_HEADS * ML_DV, 4 * ML_HEADS,
    MLA_Q_RANK, MLA_KV_RANK, MLA_ROPE,
    NA_HEADS * NA_DH, NA_HEADS * NA_DH, NA_HEADS * NA_DH,
    N_BRANCH * D_MODEL,
)
D_IN = sum(IN_SIZES)

kernel_name = 'hybrid_mlstm_mla_natten_dit'


def rms_norm(x, g):
    xf = x.astype(jnp.float32)
    y = xf * lax.rsqrt(jnp.mean(xf * xf, axis=-1, keepdims=True) + EPS)
    return (y * g.astype(jnp.float32)).astype(x.dtype)


def split_heads(t, n_heads):
    b, s, _ = t.shape
    return t.reshape(b, s, n_heads, -1)


def swap_ht(t):
    return t.transpose(0, 2, 1, 3)


def split_in(p):
    offsets = np.cumsum(IN_SIZES)[:-1].tolist()
    return jnp.split(p, offsets, axis=-1)


def attend(q, k, v, scale):
    s = jnp.einsum('bhqd,bhkd->bhqk', q, k).astype(jnp.float32) * scale
    p = jax.nn.softmax(s, axis=-1).astype(v.dtype)
    return jnp.einsum('bhqk,bhkd->bhqd', p, v)


def attend_blocked(q, k, v, scale):
    b, h, t, d = q.shape
    nb = t // Q_BLOCK
    qb = q.reshape(b, h, nb, Q_BLOCK, d).transpose(2, 0, 1, 3, 4)
    o = lax.map(lambda qi: attend(qi, k, v, scale), qb)
    return o.transpose(1, 2, 0, 3, 4).reshape(b, h, t, v.shape[-1])


def axial_rope_tables(t, dtype):
    nf = MLA_ROPE // 4
    inv = jnp.power(ROPE_THETA, -jnp.arange(nf, dtype=jnp.float32) / nf)
    pos = jnp.arange(t)
    ang_r = (pos // GRID_W).astype(jnp.float32)[:, None] * inv
    ang_c = (pos % GRID_W).astype(jnp.float32)[:, None] * inv
    return tuple(a[None, :, None, :].astype(dtype) for a in (jnp.cos(ang_r), jnp.sin(ang_r), jnp.cos(ang_c), jnp.sin(ang_c)))


def rotate(x, cos, sin):
    x1, x2 = jnp.split(x, 2, axis=-1)
    return jnp.concatenate([x1 * cos - x2 * sin, x2 * cos + x1 * sin], axis=-1)


def axial_rope(x, tabs):
    cos_r, sin_r, cos_c, sin_c = tabs
    half = x.shape[-1] // 2
    return jnp.concatenate([rotate(x[..., :half], cos_r, sin_r), rotate(x[..., half:], cos_c, sin_c)], axis=-1)


def mlstm_chunked(q, k, v, ig, lf, state, want_h):
    b, h, t, dk = q.shape
    nc = t // ML_CHUNK

    def chunks(a):
        return jnp.moveaxis(a.reshape(b, h, nc, ML_CHUNK, *a.shape[3:]), 2, 0)

    xs = tuple(chunks(a) for a in (q * dk ** -0.5, k, v, ig, lf))
    lower = jnp.tril(jnp.ones((ML_CHUNK, ML_CHUNK), dtype=bool))

    def step(carry, inp):
        C, n, m = carry
        qc, kc, vc, ic, fc = inp
        bcum = jnp.cumsum(fc, axis=-1)
        btot = bcum[..., -1]
        w_end = btot[..., None] - bcum + ic
        m_new = jnp.maximum(btot + m, jnp.max(w_end, axis=-1))
        a_state = jnp.exp(btot + m - m_new)
        wk = jnp.exp(w_end - m_new[..., None])
        C_new = a_state[..., None, None] * C + jnp.einsum('bhl,bhld,bhle->bhde', wk, kc, vc)
        n_new = a_state[..., None] * n + jnp.einsum('bhl,bhld->bhd', wk, kc)
        carry_new = (C_new, n_new, m_new)
        if not want_h:
            return carry_new, None
        dmat = jnp.where(lower, bcum[..., :, None] - bcum[..., None, :] + ic[..., None, :], -jnp.inf)
        inter = bcum + m[..., None]
        m_t = jnp.maximum(inter, jnp.max(dmat, axis=-1))
        a_inter = jnp.exp(inter - m_t)
        s = jnp.einsum('bhtd,bhsd->bhts', qc, kc) * jnp.exp(dmat - m_t[..., None])
        num = a_inter[..., None] * jnp.einsum('bhtd,bhde->bhte', qc, C) + jnp.einsum('bhts,bhse->bhte', s, vc)
        den = a_inter * jnp.einsum('bhtd,bhd->bht', qc, n) + jnp.sum(s, axis=-1)
        h_out = num / jnp.maximum(jnp.abs(den), jnp.exp(-m_t))[..., None]
        return carry_new, h_out

    state, hs = lax.scan(step, state, xs)
    if not want_h:
        return None, state
    return jnp.moveaxis(hs, 0, 2).reshape(b, h, t, -1), state


def mlstm_branch(lat, ctx, i_bias, f_bias, g_out, w_o, want_ctx):
    f32 = jnp.float32

    def prep(q, k, v, gates):
        b, t, _ = q.shape
        qh, kh, vh = (swap_ht(split_heads(a, ML_HEADS)).astype(f32) for a in (q, k, v))
        g = gates.astype(f32).reshape(b, t, 4, ML_HEADS).transpose(2, 0, 3, 1)
        dirs = [(g[2 * d] + i_bias[d].astype(f32)[None, :, None],
                 jax.nn.log_sigmoid(g[2 * d + 1] + f_bias[d].astype(f32)[None, :, None])) for d in range(2)]
        return qh, kh, vh, dirs

    ql, kl, vl, dl = prep(lat[0], lat[1], lat[2], lat[4])
    qc, kc, vc, dc = prep(ctx[0], ctx[1], ctx[2], ctx[4])
    b = qc.shape[0]
    zero = (jnp.zeros((b, ML_HEADS, ML_DQK, ML_DV), f32), jnp.zeros((b, ML_HEADS, ML_DQK), f32), jnp.zeros((b, ML_HEADS), f32))
    h_lat, h_ctx = [], []
    for d in range(2):
        flip = (lambda a: jnp.flip(a, axis=2)) if d == 1 else (lambda a: a)
        hc_d, st = mlstm_chunked(flip(qc), flip(kc), flip(vc), flip(dc[d][0]), flip(dc[d][1]), zero, want_ctx)
        hl_d, _ = mlstm_chunked(flip(ql), flip(kl), flip(vl), flip(dl[d][0]), flip(dl[d][1]), st, True)
        h_lat.append(flip(hl_d))
        if want_ctx:
            h_ctx.append(flip(hc_d))

    def out(hsum, o):
        bb, _, t, _ = hsum.shape
        hn = rms_norm(swap_ht(hsum), g_out.reshape(ML_HEADS, ML_DV)).reshape(bb, t, -1).astype(o.dtype)
        return (hn * jax.nn.sigmoid(o)) @ w_o

    y = out(h_lat[0] + h_lat[1], lat[3])
    yc = out(h_ctx[0] + h_ctx[1], ctx[3]) if want_ctx else None
    return y, yc


def mla_branch(lat, ctx, g_cq, w_uq, g_ckv, w_ukv, g_q, g_k, w_o, rope, want_ctx):
    scale = (MLA_NOPE + MLA_ROPE) ** -0.5

    def qkv(dq, dkv, kr, rope_tabs, need_q):
        b, t, _ = dkv.shape
        kv = (rms_norm(dkv, g_ckv) @ w_ukv).reshape(b, t, MLA_HEADS, MLA_NOPE + MLA_V)
        k_r = jnp.broadcast_to(kr[:, :, None, :], (b, t, MLA_HEADS, MLA_ROPE))
        k = rms_norm(jnp.concatenate([kv[..., :MLA_NOPE], k_r], axis=-1), g_k)
        q = None
        if need_q:
            q = rms_norm((rms_norm(dq, g_cq) @ w_uq).reshape(b, t, MLA_HEADS, MLA_NOPE + MLA_ROPE), g_q)
        if rope_tabs is not None:
            k = jnp.concatenate([k[..., :MLA_NOPE], axial_rope(k[..., MLA_NOPE:], rope_tabs)], axis=-1)
            q = jnp.concatenate([q[..., :MLA_NOPE], axial_rope(q[..., MLA_NOPE:], rope_tabs)], axis=-1)
        return (swap_ht(q) if need_q else None), swap_ht(k), swap_ht(kv[..., MLA_NOPE:])

    ql, kl, vl = qkv(*lat, rope, True)
    qc, kc, vc = qkv(*ctx, None, want_ctx)
    k_all = jnp.concatenate([kc, kl], axis=2)
    v_all = jnp.concatenate([vc, vl], axis=2)
    o = attend_blocked(ql, k_all, v_all, scale)
    b, _, t, _ = o.shape
    y = swap_ht(o).reshape(b, t, -1) @ w_o
    yc = None
    if want_ctx:
        oc = attend(qc, kc, vc, scale)
        yc = swap_ht(oc).reshape(b, oc.shape[2], -1) @ w_o
    return y, yc


def natten_branch(lat, ctx, g_q, g_k, rpb, w_o, want_ctx):
    scale = NA_DH ** -0.5
    f32 = jnp.float32

    def heads(q, k, v):
        q, k, v = (split_heads(a, NA_HEADS) for a in (q, k, v))
        return swap_ht(rms_norm(q, g_q)), swap_ht(rms_norm(k, g_k)), swap_ht(v)

    ql, kl, vl = heads(*lat)
    qc, kc, vc = heads(*ctx)
    b, h, t, dh = ql.shape
    rows = t // GRID_W
    wr = min(NA_WIN_R, rows)
    n_band = wr * GRID_W
    kg = kl.reshape(b, h, rows, GRID_W, dh)
    vg = vl.reshape(b, h, rows, GRID_W, dh)
    col = jnp.arange(GRID_W)
    cs = jnp.clip(col - NA_WIN_C // 2, 0, GRID_W - NA_WIN_C)
    col_ok = (col[None, :] >= cs[:, None]) & (col[None, :] < cs[:, None] + NA_WIN_C)
    dc_idx = jnp.clip(col[None, :] - col[:, None] + NA_WIN_C - 1, 0, 2 * NA_WIN_C - 2)

    def one_row(args):
        r, q_row = args
        rs = jnp.clip(r - wr // 2, 0, rows - wr)
        k_band = lax.dynamic_slice_in_dim(kg, rs, wr, axis=2)
        v_band = lax.dynamic_slice_in_dim(vg, rs, wr, axis=2)
        dr_idx = rs + jnp.arange(wr) - r + NA_WIN_R - 1
        bias = rpb[:, dr_idx[None, :, None], dc_idx[:, None, :]].astype(f32)
        s_win = jnp.einsum('bhqd,bhrkd->bhqrk', q_row, k_band).astype(f32) * scale + bias
        s_win = jnp.where(col_ok[:, None, :], s_win, NEG_INF)
        s_ctx = jnp.einsum('bhqd,bhcd->bhqc', q_row, kc).astype(f32) * scale
        p = jax.nn.softmax(jnp.concatenate([s_win.reshape(b, h, GRID_W, n_band), s_ctx], axis=-1), axis=-1).astype(vl.dtype)
        return (jnp.einsum('bhqn,bhnd->bhqd', p[..., :n_band], v_band.reshape(b, h, n_band, dh))
                + jnp.einsum('bhqc,bhcd->bhqd', p[..., n_band:], vc))

    o = lax.map(one_row, (jnp.arange(rows), jnp.moveaxis(ql.reshape(b, h, rows, GRID_W, dh), 2, 0)))
    y = o.transpose(1, 0, 3, 2, 4).reshape(b, t, h * dh) @ w_o
    yc = None
    if want_ctx:
        oc = attend(qc, kc, vc, scale)
        yc = swap_ht(oc).reshape(b, oc.shape[2], -1) @ w_o
    return y, yc


def merge(y_a, y_b, y_c, gate_pre, w_out):
    g = jax.nn.sigmoid(gate_pre.astype(jnp.float32)).astype(y_a.dtype)
    g_a, g_b, g_c = jnp.split(g, N_BRANCH, axis=-1)
    return (g_a * y_a + g_b * y_b + g_c * y_c) @ w_out


def token_mixer(h, hc, rope, want_ctx, w_in, ml_i_bias, ml_f_bias, ml_g_out, ml_w_o,
                mla_g_cq, mla_w_uq, mla_g_ckv, mla_w_ukv, mla_g_q, mla_g_k, mla_w_o,
                na_g_q, na_g_k, na_rpb, na_w_o, w_out):
    p = split_in(h @ w_in)
    pc = split_in(hc @ w_in)
    y_a, yc_a = mlstm_branch(p[0:5], pc[0:5], ml_i_bias, ml_f_bias, ml_g_out, ml_w_o, want_ctx)
    y_b, yc_b = mla_branch(p[5:8], pc[5:8], mla_g_cq, mla_w_uq, mla_g_ckv, mla_w_ukv, mla_g_q, mla_g_k, mla_w_o, rope, want_ctx)
    y_c, yc_c = natten_branch(p[8:11], pc[8:11], na_g_q, na_g_k, na_rpb, na_w_o, want_ctx)
    y = merge(y_a, y_b, y_c, p[11], w_out)
    yc = merge(yc_a, yc_b, yc_c, pc[11], w_out) if want_ctx else None
    return y, yc


def sqrelu_mlp(h, w1, w2):
    return jnp.square(jax.nn.relu(h @ w1)) @ w2


def setup_inputs(seed: int = 0) -> dict:
    key = jax.random.key(seed)
    ks = iter(jax.random.split(key, 32))

    def nrm(shape, s):
        return jax.random.normal(next(ks), shape, jnp.float32) * s

    L, D = DEPTH, D_MODEL
    return {
        'x': nrm((BATCH, SEQ, D), 1.0),
        'c': nrm((BATCH, D), 1.0),
        'ctx': nrm((BATCH, CTX_LEN, D), 1.0),
        'c_ctx': nrm((D,), 1.0),
        'w_mod': nrm((L, D, 6 * D), 0.3 * D ** -0.5),
        'b_mod': nrm((L, 6 * D), 0.02),
        'g_norm1': 1.0 + nrm((L, D), 0.05),
        'g_norm2': 1.0 + nrm((L, D), 0.05),
        'w_in': nrm((L, D, D_IN), D ** -0.5),
        'ml_i_bias': nrm((L, 2, ML_HEADS), 0.1),
        'ml_f_bias': 3.0 + nrm((L, 2, ML_HEADS), 0.5),
        'ml_g_out': 1.0 + nrm((L, ML_HEADS * ML_DV), 0.05),
        'ml_w_o': nrm((L, ML_HEADS * ML_DV, D), (ML_HEADS * ML_DV) ** -0.5),
        'mla_g_cq': 1.0 + nrm((L, MLA_Q_RANK), 0.05),
        'mla_w_uq': nrm((L, MLA_Q_RANK, MLA_HEADS * (MLA_NOPE + MLA_ROPE)), MLA_Q_RANK ** -0.5),
        'mla_g_ckv': 1.0 + nrm((L, MLA_KV_RANK), 0.05),
        'mla_w_ukv': nrm((L, MLA_KV_RANK, MLA_HEADS * (MLA_NOPE + MLA_V)), MLA_KV_RANK ** -0.5),
        'mla_g_q': 1.0 + nrm((L, MLA_NOPE + MLA_ROPE), 0.05),
        'mla_g_k': 1.0 + nrm((L, MLA_NOPE + MLA_ROPE), 0.05),
        'mla_w_o': nrm((L, MLA_HEADS * MLA_V, D), (MLA_HEADS * MLA_V) ** -0.5),
        'na_g_q': 1.0 + nrm((L, NA_DH), 0.05),
        'na_g_k': 1.0 + nrm((L, NA_DH), 0.05),
        'na_rpb': nrm((L, NA_HEADS, 2 * NA_WIN_R - 1, 2 * NA_WIN_C - 1), 0.5),
        'na_w_o': nrm((L, NA_HEADS * NA_DH, D), (NA_HEADS * NA_DH) ** -0.5),
        'w_out': nrm((L, D, D), D ** -0.5),
        'w_ff1': nrm((L, D, D_FF), D ** -0.5),
        'w_ff2': nrm((L, D_FF, D), D_FF ** -0.5),
    }


def reference(x, c, ctx, c_ctx, w_mod, b_mod, g_norm1, g_norm2, w_in, ml_i_bias, ml_f_bias, ml_g_out, ml_w_o,
              mla_g_cq, mla_w_uq, mla_g_ckv, mla_w_ukv, mla_g_q, mla_g_k, mla_w_o,
              na_g_q, na_g_k, na_rpb, na_w_o, w_out, w_ff1, w_ff2):
    rope = axial_rope_tables(x.shape[1], x.dtype)
    xc = ctx
    for l in range(DEPTH):
        want_ctx = l < DEPTH - 1
        mod = jax.nn.silu(c) @ w_mod[l] + b_mod[l]
        sh1, sc1, g1, sh2, sc2, g2 = jnp.split(mod[:, None, :], 6, axis=-1)
        modc = jax.nn.silu(c_ctx) @ w_mod[l] + b_mod[l]
        shc1, scc1, gc1, shc2, scc2, gc2 = jnp.split(modc, 6, axis=-1)
        h = rms_norm(x, g_norm1[l]) * (1 + sc1) + sh1
        hc = rms_norm(xc, g_norm1[l]) * (1 + scc1) + shc1
        y, yc = token_mixer(h, hc, rope, want_ctx, w_in[l], ml_i_bias[l], ml_f_bias[l], ml_g_out[l], ml_w_o[l],
                            mla_g_cq[l], mla_w_uq[l], mla_g_ckv[l], mla_w_ukv[l], mla_g_q[l], mla_g_k[l], mla_w_o[l],
                            na_g_q[l], na_g_k[l], na_rpb[l], na_w_o[l], w_out[l])
        x = x + g1 * y
        x = x + g2 * sqrelu_mlp(rms_norm(x, g_norm2[l]) * (1 + sc2) + sh2, w_ff1[l], w_ff2[l])
        if want_ctx:
            xc = xc + gc1 * yc
            xc = xc + gc2 * sqrelu_mlp(rms_norm(xc, g_norm2[l]) * (1 + scc2) + shc2, w_ff1[l], w_ff2[l])
    return x
```

```cpp
#include <hip/hip_runtime.h>
#include <hip/hip_cooperative_groups.h>
#include <cstdio>
#include <cstdint>
namespace cg = cooperative_groups;

#define DI __device__ __forceinline__
#define LAS __attribute__((address_space(3)))
typedef unsigned short bf16_t;
typedef short bf16x8 __attribute__((ext_vector_type(8)));
typedef float f32x4 __attribute__((ext_vector_type(4)));
typedef float f32x16 __attribute__((ext_vector_type(16)));
typedef float f32x2_t __attribute__((ext_vector_type(2)));
typedef __bf16 bf16x2_t __attribute__((ext_vector_type(2)));
typedef unsigned u32x4 __attribute__((ext_vector_type(4)));
typedef unsigned u32x2 __attribute__((ext_vector_type(2)));

constexpr int D = 1024, NBATCH = 8, SEQ = 4096, CTXL = 256, DFF = 4096, DEPTH = 2;
constexpr int GB = 4, NGROUP = 2;
constexpr int MG_LAT = GB * SEQ, MG_CTX = GB * CTXL, MG = MG_LAT + MG_CTX;
constexpr int M_LAT = NBATCH * SEQ, M_CTX = NBATCH * CTXL, M_ALL = M_LAT + M_CTX;
constexpr int D_IN = 6832, NP = 6912;
constexpr int TALL = CTXL + SEQ;
constexpr int PC_MLQ = 0, PC_MLK = 256, PC_MLV = 512, PC_MLO = 1024, PC_NAQ = 1536, PC_NAK = 2048, PC_NAV = 2560,
              PC_DQ = 3072, PC_DKV = 3456, PC_KR = 3712, PC_GT = 3744, PC_MG = 3840;
constexpr int PC_AMLA = 3072, PC_Z = 2048;
constexpr int TW = 1792;
constexpr float EPS = 1e-6f;
constexpr float LOG2E = 1.4426950408889634f;

constexpr size_t MiB = 1u << 20;
constexpr size_t WS_CTL = 0, WS_ROPE = 512 * 1024, WS_MOD = 1 * MiB, WS_W = 2 * MiB, W_LAYER = 36 * MiB;
constexpr size_t WO_IN = 0, WO_MLWO = 13 * MiB + 512 * 1024, WO_MLAWO = WO_MLWO + 1 * MiB, WO_NAWO = WO_MLAWO + 1 * MiB, WO_UQ = WO_NAWO + 1 * MiB, WO_UKV = WO_UQ + 576 * 1024,
                 WO_WOUT = WO_UKV + 768 * 1024, WO_FF1 = WO_WOUT + 2 * MiB, WO_FF2 = WO_FF1 + 8 * MiB;
static_assert(WO_FF2 + 8 * MiB <= W_LAYER, "weights");
constexpr size_t WS_XCTX = 74 * MiB, WS_QC = 82 * MiB, WS_REG = 84 * MiB;
constexpr size_t WS_H = WS_REG, WS_P = 118 * MiB, WS_Q = 348 * MiB, WS_K = 372 * MiB, WS_V = 398 * MiB, WS_HD0 = 415 * MiB, WS_HD1 = 432 * MiB, WS_T = 415 * MiB;
constexpr size_t WS_ANA = 450 * MiB;
constexpr size_t WS_H2 = WS_REG, WS_U = 152 * MiB;
constexpr size_t WS_END = 511 * MiB;
static_assert(WS_P + (size_t)MG * NP * 2 <= WS_Q && WS_T + (size_t)MG * TW * 2 <= WS_END && WS_U + (size_t)M_ALL * DFF * 2 <= WS_END, "ws map");

constexpr int LDS_BYTES = 147456;

DI unsigned pk2(float lo, float hi) { f32x2_t v = {lo, hi}; bf16x2_t b = __builtin_convertvector(v, bf16x2_t); return __builtin_bit_cast(unsigned, b); }
DI bf16_t f2bf(float f) { return (bf16_t)(pk2(f, 0.f) & 0xffffu); }
DI float bf2f(bf16_t v) { return __uint_as_float(((unsigned)v) << 16); }
DI float bflo(unsigned w) { return __uint_as_float(w << 16); }
DI float bfhi(unsigned w) { return __uint_as_float(w & 0xffff0000u); }
template <int CTRL> DI float dpp_f(float v) { return __int_as_float(__builtin_amdgcn_update_dpp(0, __float_as_int(v), CTRL, 0xF, 0xF, true)); }
DI float sum4(float v) { v += dpp_f<0xB1>(v); v += dpp_f<0x4E>(v); return v; }
DI float sum8(float v) { v = sum4(v); v += dpp_f<0x141>(v); return v; }
DI float sum16(float v) { v = sum8(v); v += dpp_f<0x140>(v); return v; }
DI float wave_sum(float v) {
    v = sum16(v);
    const int iv = __float_as_int(v);
    return (__int_as_float(__builtin_amdgcn_readlane(iv, 0)) + __int_as_float(__builtin_amdgcn_readlane(iv, 16))) + (__int_as_float(__builtin_amdgcn_readlane(iv, 32)) + __int_as_float(__builtin_amdgcn_readlane(iv, 48)));
}
DI float shx(float v, int lane, int m) { return __int_as_float(__builtin_amdgcn_ds_bpermute((lane ^ m) << 2, __float_as_int(v))); }
DI float shu(float v, int lane, int d) { return __int_as_float(__builtin_amdgcn_ds_bpermute(((lane - d) & 63) << 2, __float_as_int(v))); }
DI float rdl63(float v) { return __int_as_float(__builtin_amdgcn_readlane(__float_as_int(v), 63)); }
DI float sigmoidf_(float x) { return __builtin_amdgcn_rcpf(1.f + __expf(-x)); }

namespace pg8 {
constexpr int BM = 256, BK = 64, HALF = 128, HTB = HALF * BK * 2, NXCD = 8, WGM = 8;
DI int lds_byte(int r, int c) { const int st = (r >> 4) * 2 + (c >> 5), rr = r & 15, cc = c & 31, ob = rr * 64 + cc * 2; return st * 1024 + (ob ^ (((ob >> 9) & 1) << 5)); }
DI void stage_rc(int b, int& R, int& C) { const int st = b / 1024, sb = b % 1024, swz = sb ^ (((sb >> 9) & 1) << 5); R = (st >> 1) * 16 + swz / 64; C = (st & 1) * 32 + (swz % 64) / 2; }
DI int perm32(int rho) { const int n = rho >> 4, i = rho & 15; return 8 * (i >> 2) + 4 * n + (i & 3); }
struct Unit { int pm, pn, br; };
struct Gemm { const bf16_t* A; int lda; const bf16_t* Bt; int M, N, K; int a1 = 0, a2 = 0; int bbr = 0; };
struct StaticOrder {
    int nM, nN, nwg, G, c;
    DI void init(int M, int N, int G_, int c_) { nM = M / BM; nN = N / BM; nwg = nM * nN; G = G_; c = c_; }
    DI bool next(int i, Unit& u) const {
        const long L = (long)i * G + c; if (L >= nwg) return false;
        int wgid = (int)L; { const int q = nwg / NXCD, r = nwg % NXCD, xcd = wgid % NXCD, off = wgid / NXCD; wgid = (xcd < r ? xcd * (q + 1) : r * (q + 1) + (xcd - r) * q) + off; }
        const int nig = WGM * nN, gid = wgid / nig, fm = gid * WGM, gsz = (nM - fm) < WGM ? (nM - fm) : WGM;
        u.pm = fm + ((wgid % nig) % gsz); u.pn = (wgid % nig) / gsz; u.br = 0; return true;
    }
    DI bool keep(const Unit&) const { return false; }
};
struct CtxSkipOrder {
    StaticOrder T; int G, c;
    DI void init(int G_, int c_) { T.init(MG_LAT, NP, G_, c_); G = G_; c = c_; }
    DI bool next(int i, Unit& u) const {
        const int L = i * G + c;
        if (L < 64 * 27) return T.next(i, u);
        const int x = L - 64 * 27; if (x >= 36) return false;
        const int q = x / 9, k = x - 9 * q;
        u.pm = 64 + q; u.pn = (k < 3) ? 1 + k : (k < 7 ? 5 + k : 6 + k); u.br = 0; return true;
    }
    DI bool keep(const Unit&) const { return false; }
};
struct SplitOrder {
    StaticOrder T; int split;
    DI void init(int M, int N, int G_, int c_, int split_) { T.init(M, N, G_, c_); split = split_; }
    DI bool next(int i, Unit& u) const { if (!T.next(i, u)) return false; u.br = (u.pn >= split) ? 1 : 0; return true; }
    DI bool keep(const Unit&) const { return false; }
};
struct MergeOrder {
    StaticOrder T;
    DI void init(int M, int N, int G_, int c_) { T.init(M, N, G_, c_); }
    DI bool next(int i, Unit& u) const { const int t = i / 3; if (!T.next(t, u)) return false; u.br = i - 3 * t; return true; }
    DI bool keep(const Unit& u) const { return u.br < 2; }
};
#define PG8_ABASE(u) ((const char*)g.A + (size_t)(u).pm * tstepA + (size_t)((u).br == 0 ? 0 : ((u).br == 1 ? g.a1 : g.a2)) * 2)
#define PG8_BBASE(u) ((const char*)g.Bt + (size_t)(u).pn * tstepB + (size_t)(u).br * g.bbr * 2)
template <class Epi, class Sched>
DI void gemm_phase(LAS unsigned char* lds, const Gemm g, const Sched& S, const Epi& E) {
    int tid = threadIdx.x; asm volatile("" : "+v"(tid));
    const int wid = __builtin_amdgcn_readfirstlane(tid >> 6), lane = tid & 63, wr = wid >> 2, wc = wid & 3, fr = lane & 15, fq = lane >> 4;
    const int K = g.K, nt = K / BK, lda = g.lda;
    unsigned voffA[2], voffB[2];
#pragma unroll
    for (int i = 0; i < 2; ++i) { int R, C; stage_rc(tid * 16 + i * 8192, R, C); const int Rb = (R & ~31) + perm32(R & 31);
        voffA[i] = (unsigned)(R * lda + C) * 2u; voffB[i] = (unsigned)(Rb * K + C) * 2u; }
    const size_t kstep = (size_t)(BK * 2);
    const size_t hstepA = (size_t)HALF * lda * 2, hstepB = (size_t)HALF * K * 2;
    const size_t tstepA = 2 * hstepA, tstepB = 2 * hstepB;
    const unsigned ldsw = (unsigned)wid * 1024u;
    const int aoff = lds_byte(wr * 64 + fr, fq * 8), boff = lds_byte(wc * 32 + fr, fq * 8);
#define PG8_SA(b, h) (((b) * 2 + (h)) * HTB)
#define PG8_SB(b, h) ((4 + (b) * 2 + (h)) * HTB)
#define PG8_STAGE(bufoff, gbase, voff) do { _Pragma("unroll") for (int _i = 0; _i < 2; ++_i) \
        __builtin_amdgcn_global_load_lds((const unsigned*)((const char*)(gbase) + (voff)[_i]), (LAS unsigned*)(lds + (bufoff) + ldsw + _i * 8192), 16, 0, 0); } while (0)
#define PG8_LDA(dst, b, h) do { _Pragma("unroll") for (int m = 0; m < 4; ++m) _Pragma("unroll") for (int k = 0; k < 2; ++k) dst[m][k] = *(const LAS bf16x8*)(lds + PG8_SA(b, h) + aoff + m * 2048 + k * 1024); } while (0)
#define PG8_LDB(dst, b, h) do { _Pragma("unroll") for (int n = 0; n < 2; ++n) _Pragma("unroll") for (int k = 0; k < 2; ++k) dst[n][k] = *(const LAS bf16x8*)(lds + PG8_SB(b, h) + boff + n * 2048 + k * 1024); } while (0)
#define PG8_MMA(ai, bj, At, Bt) do { __builtin_amdgcn_s_setprio(1); _Pragma("unroll") for (int m = 0; m < 4; ++m) _Pragma("unroll") for (int n = 0; n < 2; ++n) _Pragma("unroll") for (int k = 0; k < 2; ++k) \
        acc[ai][bj][m][n] = __builtin_amdgcn_mfma_f32_16x16x32_bf16(Bt[n][k], At[m][k], acc[ai][bj][m][n], 0, 0, 0); __builtin_amdgcn_s_setprio(0); } while (0)
#define PG8_WAIT_V(n) asm volatile("s_waitcnt vmcnt(" #n ")" ::: "memory")
#define PG8_WAIT_L(n) asm volatile("s_waitcnt lgkmcnt(" #n ")" ::: "memory")
#define PG8_BAR __builtin_amdgcn_s_barrier()
#define PG8_SCHED __builtin_amdgcn_sched_barrier(0)
    Unit cur, nxt; int ui = 0;
    if (!S.next(0, cur)) return;
    f32x4 acc[2][2][4][2];
#pragma unroll
    for (int a = 0; a < 2; ++a)
#pragma unroll
        for (int b = 0; b < 2; ++b)
#pragma unroll
            for (int m = 0; m < 4; ++m)
#pragma unroll
                for (int n = 0; n < 2; ++n) acc[a][b][m][n] = (f32x4){0.f, 0.f, 0.f, 0.f};
    bf16x8 At[4][2], B0[2][2], B1[2][2];
    const char* cA = PG8_ABASE(cur); const char* cB = PG8_BBASE(cur);
    PG8_STAGE(PG8_SB(0, 0), cB, voffB); PG8_STAGE(PG8_SB(0, 1), cB + hstepB, voffB); PG8_STAGE(PG8_SA(0, 0), cA, voffA); PG8_STAGE(PG8_SA(0, 1), cA + hstepA, voffA);
    if (wr == 1) PG8_BAR;
    PG8_WAIT_V(2); PG8_BAR;
    PG8_STAGE(PG8_SB(1, 0), cB + kstep, voffB); PG8_STAGE(PG8_SA(1, 0), cA + kstep, voffA); PG8_STAGE(PG8_SB(1, 1), cB + hstepB + kstep, voffB);
    PG8_WAIT_V(6); PG8_BAR;
    for (;;) {
        const bool has_next = S.next(ui + 1, nxt);
        const char* nA = has_next ? PG8_ABASE(nxt) : cA; const char* nB = has_next ? PG8_BBASE(nxt) : cB;
        for (int t = 0; t < nt; t += 2) {
            const bool last = (t == nt - 2);
            const char* a1 = cA + (size_t)(t + 1) * kstep;
            const char* a2 = last ? nA : cA + (size_t)(t + 2) * kstep; const char* b2 = last ? nB : cB + (size_t)(t + 2) * kstep;
            const char* a3 = a2 + kstep; const char* b3 = b2 + kstep;
            PG8_LDB(B0, 0, 0); PG8_LDB(B1, 0, 1); PG8_SCHED; PG8_LDA(At, 0, 0); PG8_STAGE(PG8_SA(1, 1), a1 + hstepA, voffA);
            PG8_WAIT_V(8); PG8_WAIT_L(0); PG8_BAR; PG8_MMA(0, 0, At, B0); PG8_MMA(0, 1, At, B1); PG8_BAR; PG8_SCHED;
            PG8_LDA(At, 0, 1); PG8_STAGE(PG8_SB(0, 0), b2, voffB); PG8_STAGE(PG8_SB(0, 1), b2 + hstepB, voffB); PG8_STAGE(PG8_SA(0, 0), a2, voffA);
            PG8_WAIT_V(8); PG8_WAIT_L(0); PG8_BAR; PG8_MMA(1, 0, At, B0); PG8_MMA(1, 1, At, B1); PG8_BAR; PG8_SCHED;
            PG8_LDB(B0, 1, 0); PG8_LDB(B1, 1, 1); PG8_SCHED; PG8_LDA(At, 1, 0); PG8_STAGE(PG8_SA(0, 1), a2 + hstepA, voffA);
            PG8_WAIT_V(8); PG8_WAIT_L(0); PG8_BAR; PG8_MMA(0, 0, At, B0); PG8_MMA(0, 1, At, B1); PG8_BAR; PG8_SCHED;
            PG8_LDA(At, 1, 1); PG8_STAGE(PG8_SB(1, 0), b3, voffB); PG8_STAGE(PG8_SB(1, 1), b3 + hstepB, voffB); PG8_STAGE(PG8_SA(1, 0), a3, voffA);
            PG8_WAIT_V(8); PG8_WAIT_L(0); PG8_BAR; PG8_MMA(1, 0, At, B0); PG8_MMA(1, 1, At, B1); PG8_BAR; PG8_SCHED;
        }
        if (wr == 0) PG8_BAR;
        { int t2 = threadIdx.x; asm volatile("" : "+v"(t2)); E(acc, cur, wr, wc, t2 & 15, (t2 & 63) >> 4); }
        if (!has_next) break;
        if (!S.keep(cur)) {
#pragma unroll
        for (int a = 0; a < 2; ++a)
#pragma unroll
            for (int b = 0; b < 2; ++b)
#pragma unroll
                for (int m = 0; m < 4; ++m)
#pragma unroll
                    for (int n = 0; n < 2; ++n) acc[a][b][m][n] = (f32x4){0.f, 0.f, 0.f, 0.f};
        }
        cur = nxt; cA = nA; cB = nB; ++ui;
        if (wr == 1) PG8_BAR;
    }
    PG8_WAIT_V(0);
    PG8_BAR;
#undef PG8_SA
#undef PG8_SB
#undef PG8_STAGE
#undef PG8_LDA
#undef PG8_LDB
#undef PG8_MMA
#undef PG8_WAIT_V
#undef PG8_WAIT_L
#undef PG8_BAR
#undef PG8_SCHED
}

struct EpiStore {
    bf16_t* O; int ldc; int act;
    DI void operator()(const f32x4 (&acc)[2][2][4][2], const Unit& u, int wr, int wc, int fr, int fq) const {
        const int row0 = u.pm * BM + wr * 64 + fr, col0 = u.pn * BM + wc * 32 + 8 * fq;
#pragma unroll
        for (int ai = 0; ai < 2; ++ai)
#pragma unroll
            for (int m = 0; m < 4; ++m) { bf16_t* rowp = O + (size_t)(row0 + ai * HALF + m * 16) * ldc + col0;
#pragma unroll
                for (int bj = 0; bj < 2; ++bj) { f32x4 v0 = acc[ai][bj][m][0], v1 = acc[ai][bj][m][1];
                    if (act == 1) {
#pragma unroll
                        for (int j = 0; j < 4; ++j) { float a = fmaxf(v0[j], 0.f), b = fmaxf(v1[j], 0.f); v0[j] = a * a; v1[j] = b * b; } }
                    u32x4 w; w.x = pk2(v0[0], v0[1]); w.y = pk2(v0[2], v0[3]); w.z = pk2(v1[0], v1[1]); w.w = pk2(v1[2], v1[3]);
                    *(u32x4*)(rowp + bj * HALF) = w; } }
    }
};
struct EpiMerge {
    bf16_t* P;
    DI void operator()(f32x4 (&acc)[2][2][4][2], const Unit& u, int wr, int wc, int fr, int fq) const {
        const int row0 = u.pm * BM + wr * 64 + fr, col0 = u.pn * BM + wc * 32 + 8 * fq;
        const int gc = PC_MG + u.br * D;
#pragma unroll
        for (int ai = 0; ai < 2; ++ai)
#pragma unroll
            for (int m = 0; m < 4; ++m) { bf16_t* rowp = P + (size_t)(row0 + ai * HALF + m * 16) * NP;
#pragma unroll
                for (int bj = 0; bj < 2; ++bj) { const int c = col0 + bj * HALF;
                    const u32x4 ga = *(const u32x4*)(rowp + gc + c);
                    float xa[8]; xa[0] = bflo(ga.x); xa[1] = bfhi(ga.x); xa[2] = bflo(ga.y); xa[3] = bfhi(ga.y); xa[4] = bflo(ga.z); xa[5] = bfhi(ga.z); xa[6] = bflo(ga.w); xa[7] = bfhi(ga.w);
                    f32x4& v0 = acc[ai][bj][m][0]; f32x4& v1 = acc[ai][bj][m][1];
                    if (u.br < 2) {
                        const u32x4 gb = *(const u32x4*)(rowp + gc + D + c);
                        float xb[8]; xb[0] = bflo(gb.x); xb[1] = bfhi(gb.x); xb[2] = bflo(gb.y); xb[3] = bfhi(gb.y); xb[4] = bflo(gb.z); xb[5] = bfhi(gb.z); xb[6] = bflo(gb.w); xb[7] = bfhi(gb.w);
#pragma unroll
                        for (int j = 0; j < 4; ++j) { v0[j] *= (1.f + __expf(-xb[j])) * __builtin_amdgcn_rcpf(1.f + __expf(-xa[j])); v1[j] *= (1.f + __expf(-xb[4 + j])) * __builtin_amdgcn_rcpf(1.f + __expf(-xa[4 + j])); }
                    } else {
                        u32x4 w; w.x = pk2(v0[0] * sigmoidf_(xa[0]), v0[1] * sigmoidf_(xa[1])); w.y = pk2(v0[2] * sigmoidf_(xa[2]), v0[3] * sigmoidf_(xa[3]));
                        w.z = pk2(v1[0] * sigmoidf_(xa[4]), v1[1] * sigmoidf_(xa[5])); w.w = pk2(v1[2] * sigmoidf_(xa[6]), v1[3] * sigmoidf_(xa[7]));
                        *(u32x4*)(rowp + PC_Z + c) = w;
                    } } }
    }
};
struct EpiRes {
    const float* src_lat; const float* src_ctx; float* dst_lat; float* dst_ctx; const float* modl; int goff; int nlat, latoff, ctxoff;
    DI void operator()(const f32x4 (&acc)[2][2][4][2], const Unit& u, int wr, int wc, int fr, int fq) const {
        const int row0 = u.pm * BM + wr * 64 + fr, col0 = u.pn * BM + wc * 32 + 8 * fq;
        const int trow = u.pm * BM;
        const bool lat = trow < nlat;
        const int b = lat ? (latoff + trow) / SEQ : NBATCH;
        const float* gate = modl + (size_t)b * 6 * D + goff;
        const float* sb = lat ? src_lat + (long)latoff * D : src_ctx + ((long)ctxoff - nlat) * D;
        float* db = lat ? dst_lat + (long)latoff * D : dst_ctx + ((long)ctxoff - nlat) * D;
        f32x4 gv[2][2];
#pragma unroll
        for (int bj = 0; bj < 2; ++bj)
#pragma unroll
            for (int n = 0; n < 2; ++n) gv[bj][n] = *(const f32x4*)(gate + col0 + bj * HALF + 4 * n);
#pragma unroll
        for (int ai = 0; ai < 2; ++ai)
#pragma unroll
            for (int m = 0; m < 4; ++m) { const size_t ro = (size_t)(row0 + ai * HALF + m * 16) * D + col0;
#pragma unroll
                for (int bj = 0; bj < 2; ++bj)
#pragma unroll
                    for (int n = 0; n < 2; ++n) { const f32x4 s = *(const f32x4*)(sb + ro + bj * HALF + 4 * n);
                        *(f32x4*)(db + ro + bj * HALF + 4 * n) = s + gv[bj][n] * acc[ai][bj][m][n]; } }
    }
};
}


#define XB_TMO      128
#define XB_XCNT(j)  (256  + 64 * (j))
#define XB_XSUB(j)  (1280 + 64 * (j))
#define XB_XGEN(j)  (2304 + 64 * (j))
#define XB_TOP      3328
#define XB_TOPGEN   3392
#define XCD_BAR_WORDS 3456
#define XB_SPIN_CAP (1u << 22)
DI unsigned xb_ld(unsigned* p)              { return __hip_atomic_load(p, __ATOMIC_RELAXED, __HIP_MEMORY_SCOPE_AGENT); }
DI unsigned xb_add(unsigned* p, unsigned v) { return __hip_atomic_fetch_add(p, v, __ATOMIC_RELAXED, __HIP_MEMORY_SCOPE_AGENT); }
DI unsigned xb_xcc_id() { return (unsigned)__builtin_amdgcn_s_getreg((3 << 11) | 20) & 0xFu; }
#define XB_SPIN(cond, bar) do { unsigned _sp = 0; while (cond) { __builtin_amdgcn_s_sleep(1); \
    if ((++_sp & 255u) == 0u) { if (xb_ld(&(bar)[XB_TMO])) break; if (_sp > XB_SPIN_CAP) { atomicAdd(&(bar)[XB_TMO], 1u); break; } } } } while (0)
struct XcdBarrier { unsigned* bar; unsigned x; volatile LAS unsigned* st; };
DI XcdBarrier xcd_barrier_post(unsigned* bar, volatile LAS unsigned* st) {
    XcdBarrier b; b.bar = bar; b.x = xb_xcc_id(); b.st = st;
    if (threadIdx.x == 0) (void)xb_add(&bar[XB_XCNT(b.x)], 1u);
    return b;
}
DI void xcd_barrier_complete(unsigned* bar, unsigned x, unsigned& nloc, unsigned& nx) {
    const unsigned G = gridDim.x * gridDim.y * gridDim.z;
    unsigned sum, cnt, mine, sp = 0u;
    for (;;) {
        sum = 0u; cnt = 0u; mine = 0u;
#pragma unroll
        for (unsigned j = 0; j < 16; ++j) { const unsigned c = xb_ld(&bar[XB_XCNT(j)]); sum += c; cnt += (c > 0u) ? 1u : 0u; mine = (j == x) ? c : mine; }
        if (sum == G) break;
        __builtin_amdgcn_s_sleep(1);
        if ((++sp & 255u) == 0u) { if (xb_ld(&bar[XB_TMO])) break; if (sp > XB_SPIN_CAP) { atomicAdd(&bar[XB_TMO], 1u); break; } }
    }
    nloc = mine > 0u ? mine : 1u; nx = cnt > 0u ? cnt : 1u;
}
DI void xcd_barrier(const XcdBarrier& b) {
    asm volatile("s_waitcnt vmcnt(0)" ::: "memory");
    __syncthreads();
    if (threadIdx.x == 0) {
        unsigned* bar = b.bar;
        __builtin_amdgcn_s_waitcnt(0);
        unsigned nloc = b.st[0], nx = b.st[1];
        if (nloc == 0u) { xcd_barrier_complete(bar, b.x, nloc, nx); b.st[0] = nloc; b.st[1] = nx; }
        const unsigned old = xb_add(&bar[XB_XSUB(b.x)], 1u);
        const unsigned gen = old / nloc;
        if (old + 1u == (gen + 1u) * nloc) {
            __builtin_amdgcn_fence(__ATOMIC_RELEASE, "agent");
            asm volatile("s_waitcnt vmcnt(0)" ::: "memory");
            const unsigned og = xb_add(&bar[XB_TOP], 1u);
            const unsigned tg = og / nx;
            if (og + 1u == (tg + 1u) * nx) xb_add(&bar[XB_TOPGEN], 1u);
            else XB_SPIN(xb_ld(&bar[XB_TOPGEN]) == tg, bar);
            __builtin_amdgcn_fence(__ATOMIC_ACQUIRE, "agent");
            xb_add(&bar[XB_XGEN(b.x)], 1u);
            asm volatile("s_waitcnt vmcnt(0)" ::: "memory");
        } else {
            XB_SPIN(xb_ld(&bar[XB_XGEN(b.x)]) == gen, bar);
            __builtin_amdgcn_fence(__ATOMIC_ACQUIRE, "agent");
            asm volatile("s_waitcnt vmcnt(0)" ::: "memory");
        }
    }
    __syncthreads();
}

struct Args {
    const float* in[27];
    float* out; unsigned char* ws;
};
typedef const __attribute__((address_space(4))) Args* KArgs;

DI int win_src_col(int np) {
    if (np < 1536) return np;
    if (np < 3072) return np + 688;
    if (np < 3744) return np - 3072 + 1552;
    if (np < 3760) return np - 3744 + 1536;
    if (np < 3840) return -1;
    return np - 80;
}
struct WJob { const float* src; bf16_t* dst; const float* rs; int K, N, kt, nt, mode; };
DI void wconv_load(const WJob& j, float (&v)[8]) {
    int tid = threadIdx.x; asm volatile("" : "+v"(tid));
    const int nl = tid & 63, ks = tid >> 6;
    const int np = j.nt * 64 + nl;
    const int sc = (j.mode == 1) ? win_src_col(np) : np;
#pragma unroll
    for (int kk = 0; kk < 8; ++kk) { const int k = j.kt * 64 + ks * 8 + kk; float x = 0.f;
        if (j.mode == 2) { v[kk] = 0.f; continue; }
        if (sc >= 0) x = j.src[(size_t)k * j.N + sc];
        if (j.rs) x *= j.rs[k];
        v[kk] = x; }
}
DI void wconv_store(char* lds, const WJob& j, const float (&v)[8]) {
    float* tile = (float*)lds;
    int tid = threadIdx.x; asm volatile("" : "+v"(tid));
    const int nl = tid & 63, ks = tid >> 6;
    __syncthreads();
#pragma unroll
    for (int kk = 0; kk < 8; ++kk) tile[(ks * 8 + kk) * 65 + nl] = v[kk];
    __syncthreads();
    const int n2 = tid >> 3, kseg = tid & 7;
    float o[8];
#pragma unroll
    for (int q = 0; q < 8; ++q) o[q] = tile[(kseg * 8 + q) * 65 + n2];
    u32x4 w; w.x = pk2(o[0], o[1]); w.y = pk2(o[2], o[3]); w.z = pk2(o[4], o[5]); w.w = pk2(o[6], o[7]);
    *(u32x4*)(j.dst + (size_t)(j.nt * 64 + n2) * j.K + j.kt * 64 + kseg * 8) = w;
}
constexpr int WT_IN = 108 * 16, WT_MLWO = 16 * 8, WT_UQ = 12 * 6, WT_UKV = 16 * 6, WT_MLAWO = 16 * 8, WT_NAWO = 16 * 8, WT_WOUT = 16 * 16, WT_FF1 = 64 * 16, WT_FF2 = 16 * 64;
constexpr int WT_LAYER = WT_IN + WT_MLWO + WT_UQ + WT_UKV + WT_MLAWO + WT_NAWO + WT_WOUT + WT_FF1 + WT_FF2;
DI WJob wconv_decode(KArgs a, int item) {
    const int l = item / WT_LAYER; int r = item % WT_LAYER;
    unsigned char* wb = a->ws + WS_W + (size_t)l * W_LAYER;
    WJob j; j.mode = 0; j.rs = nullptr; int NT;
    if (r < WT_IN) { j.src = a->in[8] + (size_t)l * D * D_IN; j.dst = (bf16_t*)(wb + WO_IN); j.K = D; j.N = D_IN; NT = 108; j.mode = 1; }
    else if ((r -= WT_IN) < WT_MLWO) { j.src = a->in[12] + (size_t)l * 512 * D; j.dst = (bf16_t*)(wb + WO_MLWO); j.K = 512; j.N = D; NT = 16; }
    else if ((r -= WT_MLWO) < WT_UQ) { j.src = a->in[14] + (size_t)l * 384 * 768; j.dst = (bf16_t*)(wb + WO_UQ); j.K = 384; j.N = 768; NT = 12; j.rs = a->in[13] + l * 384; }
    else if ((r -= WT_UQ) < WT_UKV) { j.src = a->in[16] + (size_t)l * 256 * 1024; j.dst = (bf16_t*)(wb + WO_UKV); j.K = 384; j.N = 1024; NT = 16; j.rs = a->in[15] + l * 256; if (r >= 16 * 4) j.mode = 2; }
    else if ((r -= WT_UKV) < WT_MLAWO) { j.src = a->in[19] + (size_t)l * 512 * D; j.dst = (bf16_t*)(wb + WO_MLAWO); j.K = 512; j.N = D; NT = 16; }
    else if ((r -= WT_MLAWO) < WT_NAWO) { j.src = a->in[23] + (size_t)l * 512 * D; j.dst = (bf16_t*)(wb + WO_NAWO); j.K = 512; j.N = D; NT = 16; }
    else if ((r -= WT_NAWO) < WT_WOUT) { j.src = a->in[24] + (size_t)l * D * D; j.dst = (bf16_t*)(wb + WO_WOUT); j.K = D; j.N = D; NT = 16; }
    else if ((r -= WT_WOUT) < WT_FF1) { j.src = a->in[25] + (size_t)l * D * DFF; j.dst = (bf16_t*)(wb + WO_FF1); j.K = D; j.N = DFF; NT = 64; }
    else { r -= WT_FF1; j.src = a->in[26] + (size_t)l * DFF * D; j.dst = (bf16_t*)(wb + WO_FF2); j.K = DFF; j.N = D; NT = 16; }
    j.nt = r % NT; j.kt = r / NT;
    return j;
}
DI void wconv_range(char* lds, KArgs a, int first, int last, int stride) {
    int it = first; float v[8];
    if (it < last) { const WJob j = wconv_decode(a, it); wconv_load(j, v); }
    while (it < last) {
        const WJob j = wconv_decode(a, it);
        const int nx = it + stride; float v2[8];
#pragma unroll
        for (int q = 0; q < 8; ++q) v2[q] = 0.f;
        if (nx < last) { const WJob jn = wconv_decode(a, nx); wconv_load(jn, v2); }
        wconv_store(lds, j, v);
#pragma unroll
        for (int q = 0; q < 8; ++q) v[q] = v2[q];
        it = nx;
    }
    __syncthreads();
}
DI void mod_item(char* lds, KArgs a, int item) {
    float* sv = (float*)lds;
    float* red = sv + 9 * 1024;
    const int tid = threadIdx.x, l = item / 96, n0 = (item % 96) * 64;
    for (int i = tid; i < 9 * 1024; i += 512) { const float c = (i < 8 * 1024) ? a->in[1][i] : a->in[3][i - 8 * 1024]; sv[i] = c / (1.f + __expf(-c)); }
    __syncthreads();
    const int kg = tid >> 6, c = tid & 63;
    const float* w = a->in[4] + (size_t)l * D * 6 * D + n0 + c;
    float acc[9];
#pragma unroll
    for (int r = 0; r < 9; ++r) acc[r] = 0.f;
    for (int k0 = kg; k0 < D; k0 += 64) { float wv[8];
#pragma unroll
        for (int q = 0; q < 8; ++q) wv[q] = w[(size_t)(k0 + 8 * q) * 6 * D];
#pragma unroll
        for (int q = 0; q < 8; ++q)
#pragma unroll
            for (int r = 0; r < 9; ++r) acc[r] += sv[r * 1024 + k0 + 8 * q] * wv[q]; }
#pragma unroll
    for (int r = 0; r < 9; ++r) red[(kg * 9 + r) * 64 + c] = acc[r];
    __syncthreads();
    float* mod = (float*)(a->ws + WS_MOD) + (size_t)l * 9 * 6 * D;
    for (int i = tid; i < 9 * 64; i += 512) { const int r = i >> 6, cc = i & 63; float s = a->in[5][(size_t)l * 6 * D + n0 + cc];
#pragma unroll
        for (int q = 0; q < 8; ++q) s += red[(q * 9 + r) * 64 + cc];
        mod[(size_t)r * 6 * D + n0 + cc] = s; }
    __syncthreads();
}

DI void unpack8(const u32x4& w, float* o) { o[0] = bflo(w.x); o[1] = bfhi(w.x); o[2] = bflo(w.y); o[3] = bfhi(w.y); o[4] = bflo(w.z); o[5] = bfhi(w.z); o[6] = bflo(w.w); o[7] = bfhi(w.w); }
DI u32x4 packv8(const float* o) { u32x4 w; w.x = pk2(o[0], o[1]); w.y = pk2(o[2], o[3]); w.z = pk2(o[4], o[5]); w.w = pk2(o[6], o[7]); return w; }
DI void norm_phase(const float* src_lat, const float* src_ctx, int nlat, int ntot, int latoff, int ctxoff,
                   const float* __restrict__ gnorm, const float* __restrict__ modl, int shoff, int scoff, bf16_t* dst) {
    int tx_ = threadIdx.x; asm volatile("" : "+v"(tx_));
    const int lane = tx_ & 63, gw = blockIdx.x * 8 + (tx_ >> 6), nw = gridDim.x * 8;
    for (int r = gw; r < ntot; r += nw) {
        const bool lat = r < nlat;
        const float* x = lat ? src_lat + (size_t)(latoff + r) * D : src_ctx + (size_t)(ctxoff + r - nlat) * D;
        const int b = lat ? (latoff + r) / SEQ : NBATCH;
        const float* mb = modl + (size_t)b * 6 * D;
        f32x4 v[4], g[4], sc[4], sh[4]; float ss = 0.f;
#pragma unroll
        for (int i = 0; i < 4; ++i) { const int c = lane * 4 + 256 * i; v[i] = *(const f32x4*)(x + c); g[i] = *(const f32x4*)(gnorm + c); sc[i] = *(const f32x4*)(mb + scoff + c); sh[i] = *(const f32x4*)(mb + shoff + c); }
#pragma unroll
        for (int i = 0; i < 4; ++i) ss += v[i][0] * v[i][0] + v[i][1] * v[i][1] + v[i][2] * v[i][2] + v[i][3] * v[i][3];
        ss = wave_sum(ss);
        const float rstd = rsqrtf(ss * (1.f / D) + EPS);
#pragma unroll
        for (int i = 0; i < 4; ++i) { const int c = lane * 4 + 256 * i;
            f32x4 y;
#pragma unroll
            for (int j = 0; j < 4; ++j) y[j] = (v[i][j] * rstd * g[i][j]) * (1.f + sc[i][j]) + sh[i][j];
            u32x2 w; w.x = pk2(y[0], y[1]); w.y = pk2(y[2], y[3]);
            *(u32x2*)(dst + (size_t)r * D + c) = w; }
    }
}

DI void prep_phase(KArgs a, int l, bool want_ctx, bf16_t* P, const bf16_t* T, bf16_t* Qb, bf16_t* Qc, bf16_t* Kb, bf16_t* Vb, const float* ropetab) {
    int tx_ = threadIdx.x; asm volatile("" : "+v"(tx_));
    const int lane = tx_ & 63, gw = blockIdx.x * 8 + (tx_ >> 6), nw = gridDim.x * 8;
    const int hd = lane >> 3, k = lane & 7;
    const float* gq = a->in[17] + l * 96; const float* gk = a->in[18] + l * 96;
    float gqn[8], gqr[4], gkn[8], gkr[4], nqw[16];
#pragma unroll
    for (int i = 0; i < 8; ++i) { gqn[i] = gq[8 * k + i]; gkn[i] = gk[8 * k + i]; }
#pragma unroll
    for (int i = 0; i < 4; ++i) { gqr[i] = gq[64 + 4 * k + i]; gkr[i] = gk[64 + 4 * k + i]; }
    const float QS = 0.10206207261596577f * LOG2E, NAS = 0.125f * LOG2E;
    { const float* nw_ = (lane < 32) ? a->in[20] + l * 64 : a->in[21] + l * 64; const float sc_ = (lane < 32) ? NAS : 1.f;
#pragma unroll
      for (int i = 0; i < 16; ++i) nqw[i] = nw_[16 * (lane & 3) + i] * sc_; }
    const int sec = k >> 2, second = (k >> 1) & 1;
    for (int r = gw; r < MG; r += nw) {
        const bool lat = r < MG_LAT;
        int bl, tt, tall;
        if (lat) { bl = r / SEQ; tt = r % SEQ; tall = CTXL + tt; } else { const int rc = r - MG_LAT; bl = rc / CTXL; tt = rc % CTXL; tall = tt; }
        const bool need_q = lat || want_ctx;
        bf16_t* Pr = P + (size_t)r * NP; const bf16_t* Tr = T + (size_t)r * TW;
        const u32x4 d0 = *(const u32x4*)(Pr + PC_DQ + 8 * lane);
        u32x4 d1 = (u32x4){0u, 0u, 0u, 0u}; if (lane < 16) d1 = *(const u32x4*)(Pr + PC_DQ + 512 + 8 * lane);
        const u32x2 krw = *(const u32x2*)(Pr + PC_KR + 4 * k);
        const u32x4 tqn = *(const u32x4*)(Tr + hd * 96 + 8 * k); const u32x2 tqr = *(const u32x2*)(Tr + hd * 96 + 64 + 4 * k);
        const u32x4 tkn = *(const u32x4*)(Tr + 768 + hd * 128 + 8 * k), tv = *(const u32x4*)(Tr + 768 + hd * 128 + 64 + 8 * k);
        u32x4 na0 = *(const u32x4*)(Pr + PC_NAQ + 16 * lane), na1 = *(const u32x4*)(Pr + PC_NAQ + 16 * lane + 8);
        f32x4 rt0 = (f32x4){1.f, 0.f, 1.f, 0.f}, rt1 = rt0;
        if (lat) { const int pos = sec ? (tt & 63) : (tt >> 6); const float* rp = ropetab + (size_t)(pos * 8 + 4 * (k & 1)) * 2; rt0 = *(const f32x4*)rp; rt1 = *(const f32x4*)(rp + 4); }
        float e0[8], e1[8]; unpack8(d0, e0); unpack8(d1, e1);
        float s0 = 0.f, s1 = 0.f;
#pragma unroll
        for (int i = 0; i < 8; ++i) { s0 += e0[i] * e0[i]; s1 += e1[i] * e1[i]; }
        const float ssq = wave_sum(lane < 48 ? s0 : 0.f), skv = wave_sum((lane < 48 ? 0.f : s0) + s1);
        const float rstd_q = rsqrtf(ssq * (1.f / 384.f) + EPS), rstd_kv = rsqrtf(skv * (1.f / 256.f) + EPS);
        const float cs4[4] = {rt0[0], rt0[2], rt1[0], rt1[2]}, sn4[4] = {rt0[1], rt0[3], rt1[1], rt1[3]};
        if (need_q) {
            float xn[8], xr[4]; unpack8(tqn, xn); xr[0] = bflo(tqr.x); xr[1] = bfhi(tqr.x); xr[2] = bflo(tqr.y); xr[3] = bfhi(tqr.y);
            float ss = 0.f;
#pragma unroll
            for (int i = 0; i < 8; ++i) { xn[i] *= rstd_q; ss += xn[i] * xn[i]; }
#pragma unroll
            for (int i = 0; i < 4; ++i) { xr[i] *= rstd_q; ss += xr[i] * xr[i]; }
            const float rs = rsqrtf(sum8(ss) * (1.f / 96.f) + EPS) ;
#pragma unroll
            for (int i = 0; i < 8; ++i) xn[i] = xn[i] * rs * gqn[i] * QS;
#pragma unroll
            for (int i = 0; i < 4; ++i) { const float y = xr[i] * rs * gqr[i]; const float xp = dpp_f<0x4E>(y); xr[i] = (second ? y * cs4[i] + xp * sn4[i] : y * cs4[i] - xp * sn4[i]) * QS; }
            bf16_t* dst = lat ? Qb + ((size_t)(bl * 8 + hd) * SEQ + tt) * 96 : Qc + ((size_t)(bl * 8 + hd) * CTXL + tt) * 96;
            *(u32x4*)(dst + 8 * k) = packv8(xn); u32x2 w; w.x = pk2(xr[0], xr[1]); w.y = pk2(xr[2], xr[3]); *(u32x2*)(dst + 64 + 4 * k) = w;
        }
        {
            float xn[8], xr[4], vv[8]; unpack8(tkn, xn); unpack8(tv, vv); xr[0] = bflo(krw.x); xr[1] = bfhi(krw.x); xr[2] = bflo(krw.y); xr[3] = bfhi(krw.y);
            float ss = 0.f;
#pragma unroll
            for (int i = 0; i < 8; ++i) { xn[i] *= rstd_kv; vv[i] *= rstd_kv; ss += xn[i] * xn[i]; }
#pragma unroll
            for (int i = 0; i < 4; ++i) ss += xr[i] * xr[i];
            const float rs = rsqrtf(sum8(ss) * (1.f / 96.f) + EPS);
#pragma unroll
            for (int i = 0; i < 8; ++i) xn[i] = xn[i] * rs * gkn[i];
#pragma unroll
            for (int i = 0; i < 4; ++i) { const float y = xr[i] * rs * gkr[i]; const float xp = dpp_f<0x4E>(y); xr[i] = second ? y * cs4[i] + xp * sn4[i] : y * cs4[i] - xp * sn4[i]; }
            bf16_t* dst = Kb + ((size_t)(bl * 8 + hd) * TALL + tall) * 96;
            *(u32x4*)(dst + 8 * k) = packv8(xn); u32x2 w; w.x = pk2(xr[0], xr[1]); w.y = pk2(xr[2], xr[3]); *(u32x2*)(dst + 64 + 4 * k) = w;
            *(u32x4*)(Vb + ((size_t)(bl * 8 + hd) * TALL + tall) * 64 + 8 * k) = packv8(vv);
        }
        {
            float x0[8], x1[8]; unpack8(na0, x0); unpack8(na1, x1);
            float ss = 0.f;
#pragma unroll
            for (int i = 0; i < 8; ++i) ss += x0[i] * x0[i] + x1[i] * x1[i];
            const float rs = rsqrtf(sum4(ss) * (1.f / 64.f) + EPS);
#pragma unroll
            for (int i = 0; i < 8; ++i) { x0[i] = x0[i] * rs * nqw[i]; x1[i] = x1[i] * rs * nqw[8 + i]; }
            *(u32x4*)(Pr + PC_NAQ + 16 * lane) = packv8(x0); *(u32x4*)(Pr + PC_NAQ + 16 * lane + 8) = packv8(x1);
        }
    }
}

DI void mlcomb_phase(KArgs a, int l, int nrows, bf16_t* P, const bf16_t* HD0, const bf16_t* HD1) {
    int tx_ = threadIdx.x; asm volatile("" : "+v"(tx_));
    const int lane = tx_ & 63, gw = blockIdx.x * 8 + (tx_ >> 6), nw = gridDim.x * 8;
    const float* gout = a->in[11] + l * 512 + 8 * lane;
    float go[8];
#pragma unroll
    for (int i = 0; i < 8; ++i) go[i] = gout[i];
    for (int r = gw; r < nrows; r += nw) {
        bf16_t* Pr = P + (size_t)r * NP + PC_MLO + 8 * lane;
        const u32x4 w0 = *(const u32x4*)(HD0 + (size_t)r * 512 + 8 * lane), w1 = *(const u32x4*)(HD1 + (size_t)r * 512 + 8 * lane), wo = *(const u32x4*)Pr;
        float h0[8], h1[8], o[8]; unpack8(w0, h0); unpack8(w1, h1); unpack8(wo, o);
        float ss = 0.f;
#pragma unroll
        for (int i = 0; i < 8; ++i) { h0[i] += h1[i]; ss += h0[i] * h0[i]; }
        const float rs = rsqrtf(sum16(ss) * (1.f / 128.f) + EPS);
#pragma unroll
        for (int i = 0; i < 8; ++i) h0[i] = h0[i] * rs * go[i] * sigmoidf_(o[i]);
        *(u32x4*)Pr = packv8(h0);
    }
}

DI float max3f(float a, float b, float c) { float r; asm("v_max3_f32 %0, %1, %2, %3" : "=v"(r) : "v"(a), "v"(b), "v"(c)); return r; }
DI float max2f(float a, float b) { float r; asm("v_max_f32_e32 %0, %1, %2" : "=v"(r) : "v"(a), "v"(b)); return r; }
typedef short s16x4 __attribute__((ext_vector_type(4)));
DI s16x4 vtr(const LAS char* p) { return __builtin_bit_cast(s16x4, __builtin_amdgcn_ds_read_tr16_b64_v4i16((LAS s16x4*)p)); }
DI int crow(int reg, int h) { return (reg & 3) + 8 * (reg >> 2) + 4 * h; }
#define MFMA32(a, b, c) __builtin_amdgcn_mfma_f32_32x32x16_bf16((a), (b), (c), 0, 0, 0)
DI bf16x8 pack8(const f32x16& x, int s) {
    u32x4 p; p.x = pk2(x[8 * s], x[8 * s + 1]); p.y = pk2(x[8 * s + 2], x[8 * s + 3]); p.z = pk2(x[8 * s + 4], x[8 * s + 5]); p.w = pk2(x[8 * s + 6], x[8 * s + 7]);
    return __builtin_bit_cast(bf16x8, p);
}
struct AttnP {
    const bf16_t* Q; int q_ld;
    const bf16_t* Kb; const bf16_t* Vb;
    const bf16_t* Kc; const bf16_t* Vc;
    bf16_t* O; int o_ld;
    int ntiles, nb, rlo, r0;
    const float* rpb;
    int fix;
    float C;
};
template <int MODE, bool FIX>
DI void attn_unit(char* lds, const AttnP& p) {
    constexpr int DQK = MODE == 0 ? 96 : 64, NST = DQK / 16, NCH = DQK / 8, KSTRB = (DQK + 8) * 2, VSTRB = 144, KBUF = 13312, VBUF = 9216;
    char* Kb0 = lds; char* Vb0 = lds + 2 * KBUF; float* rpbL = (float*)(lds + 2 * KBUF + 2 * VBUF);
    int tid = threadIdx.x; asm volatile("" : "+v"(tid));
    const int w = tid >> 6, lane = tid & 63, r = lane & 31, h = lane >> 5;
    const int nt = p.ntiles;
    bf16x8 qf[NST];
    { const bf16_t* qp = p.Q + (size_t)(32 * w + r) * p.q_ld + 8 * h;
#pragma unroll
      for (int st = 0; st < NST; ++st) qf[st] = *(const bf16x8*)(qp + 16 * st); }
    f32x16 o0, o1, p0, p1, n0, n1;
#pragma unroll
    for (int i = 0; i < 16; ++i) { o0[i] = 0.f; o1[i] = 0.f; p0[i] = 0.f; p1[i] = 0.f; n0[i] = 0.f; n1[i] = 0.f; }
    float m_run = -1e30f, l_run = 0.f;
    const float sinit = FIX ? -p.C : 0.f;
    const int rq = p.r0 + (w >> 1), rs = min(max(rq - 4, 0), 56), qc = 32 * (w & 1) + r, cs = min(max(qc - 8, 0), 48);
    unsigned idxp0[4], idxp1[4];
    if (MODE == 1) {
        for (int i = tid; i < 480; i += 512) { const int dr = i >> 5, d = i & 31; rpbL[i] = (d < 31) ? p.rpb[dr * 31 + d] * LOG2E : -1e30f; }
#pragma unroll
        for (int k4 = 0; k4 < 4; ++k4) { unsigned a0 = 0u, a1 = 0u;
#pragma unroll
            for (int m = 0; m < 4; ++m) { const int i = 4 * k4 + m; const int c0 = crow(i, h), c1 = 32 + c0;
                a0 |= (unsigned)((((unsigned)(c0 - cs) < 16u) ? (c0 - qc + 15) : 31) * 4) << (8 * m);
                a1 |= (unsigned)((((unsigned)(c1 - cs) < 16u) ? (c1 - qc + 15) : 31) * 4) << (8 * m); }
            idxp0[k4] = a0; idxp1[k4] = a1; }
    }
    const int krow0 = tid / NCH, kch0 = tid % NCH, krow1 = (tid + 512) / NCH, kch1 = (tid + 512) % NCH;
    const bool k2 = (MODE == 0) && (tid < 256);
    const int vkey = tid >> 3, vdg = tid & 7;
    u32x4 kr0, kr1 = (u32x4){0u, 0u, 0u, 0u}, vr, kx0 = (u32x4){0u, 0u, 0u, 0u}, kx1 = (u32x4){0u, 0u, 0u, 0u}, vx = (u32x4){0u, 0u, 0u, 0u};
#define ATT_KV(j) const bf16_t* kp; const bf16_t* vp; size_t kld, vld; \
        if (MODE == 0) { kp = p.Kb + (size_t)(j) * 64 * 96; vp = p.Vb + (size_t)(j) * 64 * 64; kld = 96; vld = 64; } \
        else if ((j) < p.nb) { kp = p.Kb + (size_t)(p.rlo + (j)) * 64 * NP; vp = p.Vb + (size_t)(p.rlo + (j)) * 64 * NP; kld = NP; vld = NP; } \
        else { kp = p.Kc + (size_t)((j) - p.nb) * 64 * NP; vp = p.Vc + (size_t)((j) - p.nb) * 64 * NP; kld = NP; vld = NP; }
#define ATT_LOADK(j) do { ATT_KV(j); (void)vp; (void)vld; kr0 = *(const u32x4*)(kp + (size_t)krow0 * kld + kch0 * 8); if (k2) kr1 = *(const u32x4*)(kp + (size_t)krow1 * kld + kch1 * 8); } while (0)
#define ATT_LOADV(j) do { ATT_KV(j); (void)kp; (void)kld; vr = *(const u32x4*)(vp + (size_t)vkey * vld + vdg * 8); } while (0)
#define ATT_LOADKX(j) do { ATT_KV(j); (void)vp; (void)vld; kx0 = *(const u32x4*)(kp + (size_t)krow0 * kld + kch0 * 8); if (k2) kx1 = *(const u32x4*)(kp + (size_t)krow1 * kld + kch1 * 8); } while (0)
#define ATT_LOADVX(j) do { ATT_KV(j); (void)kp; (void)kld; vx = *(const u32x4*)(vp + (size_t)vkey * vld + vdg * 8); } while (0)
#define ATT_STOREK(b) do { char* Ks_ = Kb0 + (b) * KBUF; *(u32x4*)(Ks_ + krow0 * KSTRB + kch0 * 16) = kr0; if (k2) *(u32x4*)(Ks_ + krow1 * KSTRB + kch1 * 16) = kr1; } while (0)
#define ATT_STOREV(b) do { *(u32x4*)(Vb0 + (b) * VBUF + vkey * VSTRB + vdg * 16) = vr; } while (0)
#define ATT_QK(S0, S1, b) do { const char* Ks_ = Kb0 + (b) * KBUF + r * KSTRB + 16 * h; \
        _Pragma("unroll") for (int i_ = 0; i_ < 16; ++i_) { S0[i_] = sinit; S1[i_] = sinit; } \
        _Pragma("unroll") for (int st = 0; st < NST; ++st) { const bf16x8 a0 = *(const bf16x8*)(Ks_ + 32 * st), a1 = *(const bf16x8*)(Ks_ + 32 * KSTRB + 32 * st); \
            S0 = MFMA32(a0, qf[st], S0); S1 = MFMA32(a1, qf[st], S1); } } while (0)
#define ATT_ACT(j) (!((MODE == 1) && ((j) < p.nb) && !((p.rlo + (j)) >= rs && (p.rlo + (j)) < rs + 8)))
    ATT_LOADK(0); ATT_LOADV(0); ATT_STOREK(0); ATT_STOREV(0);
    if (nt > 1) { ATT_LOADK(1); ATT_STOREK(1); }
    if (nt > 2) ATT_LOADK(2);
    if (nt > 1) ATT_LOADV(1);
    __syncthreads();
    if (ATT_ACT(0)) ATT_QK(p0, p1, 0);
    __syncthreads();
    int j = 0;
#pragma unroll
    for (int ph = 0; ph < 2; ++ph) {
    const bool FULL = (ph == 0);
    const int jend = FULL ? nt - 3 : nt;
    for (; j < jend; ++j) {
        if (FULL || j + 2 < nt) ATT_STOREK(j & 1);
        if (FULL || j + 1 < nt) ATT_STOREV((j + 1) & 1);
        if (FULL || j + 3 < nt) ATT_LOADK(j + 3);
        if (FULL || j + 2 < nt) ATT_LOADV(j + 2);
        const bool an_ = (MODE == 0) ? true : ((FULL || j + 1 < nt) && ATT_ACT(j + 1));
        const bool ac_ = ATT_ACT(j);
        const bool bd_ = (MODE == 1) && (j < p.nb);
#pragma unroll
        for (int vv = 0; vv < 3; ++vv) {
        if (MODE == 0 && vv != 1) continue;
        const bool sel_ = (MODE == 0) ? true : ((vv == 0) ? (an_ && ac_ && bd_) : ((vv == 1) ? (an_ && ac_ && !bd_) : !(an_ && ac_)));
        if (!sel_) continue;
        const bool doqk_ = (vv < 2) ? true : an_, dosm_ = (vv < 2) ? true : ac_, band_ = (vv == 0) ? true : ((vv == 1) ? false : bd_);
        if (doqk_) { ATT_QK(n0, n1, (j + 1) & 1); }
        if (dosm_) {
            if (band_) {
                const char* browb = (const char*)(rpbL + (p.rlo + j - rq + 7) * 32);
#pragma unroll
                for (int i = 0; i < 16; ++i) { p0[i] += *(const float*)(browb + ((idxp0[i >> 2] >> (8 * (i & 3))) & 0xffu)); p1[i] += *(const float*)(browb + ((idxp1[i >> 2] >> (8 * (i & 3))) & 0xffu)); }
            }
            if (FIX) {
#pragma unroll
                for (int i = 0; i < 16; ++i) { p0[i] = __builtin_amdgcn_exp2f(p0[i]); p1[i] = __builtin_amdgcn_exp2f(p1[i]); }
                const f32x16 ps = p0 + p1;
                l_run += ((ps[0] + ps[1]) + (ps[2] + ps[3])) + ((ps[4] + ps[5]) + (ps[6] + ps[7])) + ((ps[8] + ps[9]) + (ps[10] + ps[11])) + ((ps[12] + ps[13]) + (ps[14] + ps[15]));
            } else {
            float tmax = max2f(p0[0], p1[0]), tmax2 = max2f(p0[1], p1[1]);
#pragma unroll
            for (int i = 2; i < 16; i += 2) { tmax = max3f(tmax, p0[i], p1[i]); tmax2 = max3f(tmax2, p0[i + 1], p1[i + 1]); }
            tmax = max2f(tmax, tmax2);
            tmax = max2f(tmax, shx(tmax, lane, 32));
            const float m_new = max2f(m_run, tmax), alpha = __builtin_amdgcn_exp2f(m_run - m_new);
            p0 = p0 - m_new; p1 = p1 - m_new;
#pragma unroll
            for (int i = 0; i < 16; ++i) { p0[i] = __builtin_amdgcn_exp2f(p0[i]); p1[i] = __builtin_amdgcn_exp2f(p1[i]); }
            const f32x16 ps = p0 + p1;
            float rsum = ((ps[0] + ps[1]) + (ps[2] + ps[3])) + ((ps[4] + ps[5]) + (ps[6] + ps[7])) + ((ps[8] + ps[9]) + (ps[10] + ps[11])) + ((ps[12] + ps[13]) + (ps[14] + ps[15]));
            rsum += shx(rsum, lane, 32);
            l_run = l_run * alpha + rsum; m_run = m_new;
            o0 = o0 * alpha; o1 = o1 * alpha;
            }
            const LAS char* vbase = (const LAS char*)(Vb0 + (j & 1) * VBUF) + (4 * h + ((lane & 15) >> 2)) * VSTRB + ((lane >> 4) & 1) * 32 + (lane & 3) * 8;
#pragma unroll
            for (int kb = 0; kb < 2; ++kb)
#pragma unroll
                for (int s = 0; s < 2; ++s) {
                    const bf16x8 pf = pack8(kb ? p1 : p0, s);
                    const LAS char* vb = vbase + (32 * kb + 16 * s) * VSTRB;
                    const s16x4 l0 = vtr(vb), h0 = vtr(vb + 8 * VSTRB), l1 = vtr(vb + 64), h1 = vtr(vb + 8 * VSTRB + 64);
                    const bf16x8 v0 = __builtin_shufflevector(l0, h0, 0, 1, 2, 3, 4, 5, 6, 7), v1 = __builtin_shufflevector(l1, h1, 0, 1, 2, 3, 4, 5, 6, 7);
                    o0 = MFMA32(v0, pf, o0); o1 = MFMA32(v1, pf, o1);
                }
        }
        }
        __syncthreads();
        p0 = n0; p1 = n1;
    }
    }
#undef ATT_KV
#undef ATT_LOADK
#undef ATT_LOADV
#undef ATT_LOADKX
#undef ATT_LOADVX
#undef ATT_STOREK
#undef ATT_STOREV
#undef ATT_QK
#undef ATT_ACT
    if (FIX) l_run += shx(l_run, lane, 32);
    const float inv = 1.f / l_run;
    bf16_t* op = p.O + (size_t)(32 * w + r) * p.o_ld + 4 * h;
#pragma unroll
    for (int i4 = 0; i4 < 4; ++i4) {
        u32x2 w0, w1; w0.x = pk2(o0[4 * i4] * inv, o0[4 * i4 + 1] * inv); w0.y = pk2(o0[4 * i4 + 2] * inv, o0[4 * i4 + 3] * inv);
        w1.x = pk2(o1[4 * i4] * inv, o1[4 * i4 + 1] * inv); w1.y = pk2(o1[4 * i4 + 2] * inv, o1[4 * i4 + 3] * inv);
        *(u32x2*)(op + 8 * i4) = w0; *(u32x2*)(op + 32 + 8 * i4) = w1;
    }
}

#define ML_ROW(ci, t) (((ci) < 4) ? (MG_LAT + bl * CTXL + (dir ? (3 - (ci)) * 64 + 63 - (t) : (ci) * 64 + (t))) : (bl * SEQ + (dir ? (67 - (ci)) * 64 + 63 - (t) : ((ci) - 4) * 64 + (t))))
constexpr int ML_NSEQ = 32, ML_NCH = 68, ML_ITEMS = ML_NSEQ * ML_NCH;
constexpr size_t WS_DC = WS_H, WS_CS = 475 * MiB, WS_SM = 509 * MiB, SM_DN = 0, SM_NST = 0x90000, SM_SCAL = 0x120000, SM_MST = 0x128000, SM_TAB = 0x130000;
DI void mlA_phase(char* lds, KArgs a, int l, const bf16_t* P, unsigned char* ws) {
    constexpr int STR = 144;
    char* KTs = lds + 18432; char* VTs = lds + 27648;
    float* tab = (float*)(lds + 64512); float* tu = tab; float* misc = tab + 384;
    int tid = threadIdx.x; asm volatile("" : "+v"(tid));
    const int w = tid >> 6, lane = tid & 63, r = lane & 31, h = lane >> 5, eb = w >> 1, xb = w & 1;
    const int srow = tid >> 3, sch = tid & 7;
    const int G = gridDim.x;
    u32x4 rk, rv0, rv1; float gi = 0.f, gf = 0.f;
#define MLA_LOAD(item) do { const int sq_ = (item) / ML_NCH, ci_ = (item) % ML_NCH, dir = sq_ & 1, hh_ = (sq_ >> 1) & 3, bl = sq_ >> 3; \
        const bf16_t* pr = P + (size_t)ML_ROW(ci_, srow) * NP; \
        rk = *(const u32x4*)(pr + PC_MLK + hh_ * 64 + sch * 8); rv0 = *(const u32x4*)(pr + PC_MLV + hh_ * 128 + sch * 8); rv1 = *(const u32x4*)(pr + PC_MLV + hh_ * 128 + 64 + sch * 8); \
        if (w == 0) { const bf16_t* pg = P + (size_t)ML_ROW(ci_, lane) * NP + PC_GT; gi = bf2f(pg[(2 * dir) * 4 + hh_]); gf = bf2f(pg[(2 * dir + 1) * 4 + hh_]); } } while (0)
    int item = blockIdx.x;
    if (item < ML_ITEMS) MLA_LOAD(item);
    for (; item < ML_ITEMS; item += G) {
        const int sq = item / ML_NCH, dir = sq & 1, hh = (sq >> 1) & 3;
        if (w == 0) {
            const float ib = a->in[9][(l * 2 + dir) * 4 + hh], fb = a->in[10][(l * 2 + dir) * 4 + hh];
            const float x = gf + fb;
            const float lf = fminf(x, 0.f) - log1pf(expf(-fabsf(x)));
            float bc = lf;
#pragma unroll
            for (int o = 1; o < 64; o <<= 1) { const float v = shu(bc, lane, o); if (lane >= o) bc += v; }
            const float u = gi + ib - bc;
            float am = u;
#pragma unroll
            for (int o = 1; o < 64; o <<= 1) { const float v = shu(am, lane, o); if (lane >= o) am = fmaxf(am, v); }
            { float* tb = (float*)(ws + WS_SM + SM_TAB) + (size_t)item * 192; tb[lane] = u; tb[64 + lane] = bc; tb[128 + lane] = am; }
            tu[lane] = u;
            const float btot = rdl63(bc); am = rdl63(am);
            if (lane == 0) { misc[1] = am; float* sc = (float*)(ws + WS_SM + SM_SCAL) + (size_t)item * 2; sc[0] = btot; sc[1] = am; }
        }
        { const unsigned vw[8] = {rv0.x, rv0.y, rv0.z, rv0.w, rv1.x, rv1.y, rv1.z, rv1.w};
#pragma unroll
          for (int i = 0; i < 8; ++i) { const int e = (i < 4 ? 0 : 64) + sch * 8 + 2 * (i & 3);
              *(bf16_t*)(VTs + e * STR + srow * 2) = (bf16_t)(vw[i] & 0xffffu); *(bf16_t*)(VTs + (e + 1) * STR + srow * 2) = (bf16_t)(vw[i] >> 16); } }
        __syncthreads();
        { const float wk = __expf(tu[srow] - misc[1]);
          const unsigned kw[4] = {rk.x, rk.y, rk.z, rk.w};
#pragma unroll
          for (int i = 0; i < 4; ++i) { *(bf16_t*)(KTs + (sch * 8 + 2 * i) * STR + srow * 2) = f2bf(bflo(kw[i]) * wk); *(bf16_t*)(KTs + (sch * 8 + 2 * i + 1) * STR + srow * 2) = f2bf(bfhi(kw[i]) * wk); } }
        if (item + G < ML_ITEMS) MLA_LOAD(item + G);
        __syncthreads();
        {
            f32x16 C;
#pragma unroll
            for (int i = 0; i < 16; ++i) C[i] = 0.f;
#pragma unroll
            for (int st = 0; st < 4; ++st) {
                const bf16x8 vA = *(const bf16x8*)(VTs + (32 * eb + r) * STR + (16 * st + 8 * h) * 2), kB = *(const bf16x8*)(KTs + (32 * xb + r) * STR + (16 * st + 8 * h) * 2);
                C = MFMA32(vA, kB, C);
            }
            bf16_t* dc = (bf16_t*)(ws + WS_DC) + (size_t)item * 8192;
#pragma unroll
            for (int i = 0; i < 16; ++i) dc[(32 * eb + crow(i, h)) * 64 + 32 * xb + r] = f2bf(C[i]);
            const u32x4 kk = *(const u32x4*)(KTs + srow * STR + sch * 16);
            float sm = bflo(kk.x) + bfhi(kk.x) + bflo(kk.y) + bfhi(kk.y) + bflo(kk.z) + bfhi(kk.z) + bflo(kk.w) + bfhi(kk.w);
            sm += shx(sm, lane, 1); sm += shx(sm, lane, 2); sm += shx(sm, lane, 4);
            if (sch == 0) ((float*)(ws + WS_SM + SM_DN))[(size_t)item * 64 + srow] = sm;
        }
        __syncthreads();
    }
#undef MLA_LOAD
}
DI void mlB_phase(char* lds, unsigned char* ws) {
    int tx_ = threadIdx.x; asm volatile("" : "+v"(tx_));
    const int gt = blockIdx.x * 512 + tx_;
    const int sq = (blockIdx.x * 512) >> 12, pi = gt & 4095;
    float* sA = (float*)lds; float* sB = sA + 80; float* sM = sA + 160; float* sBt = sA + 240; float* sMl = sA + 320;
    if (sq >= ML_NSEQ) return;
    if (tx_ < ML_NCH) { const float* sc = (const float*)(ws + WS_SM + SM_SCAL) + ((size_t)sq * ML_NCH + tx_) * 2; sBt[tx_] = sc[0]; sMl[tx_] = sc[1]; }
    __syncthreads();
    if (tx_ == 0) { float m = 0.f;
        for (int ci = 0; ci < ML_NCH; ++ci) { const float M = fmaxf(m, sMl[ci]); sA[ci] = __expf(m - M); sB[ci] = __expf(sMl[ci] - M); sM[ci] = m; m = sBt[ci] + M; } }
    __syncthreads();
    const unsigned* __restrict__ dc = (const unsigned*)(ws + WS_DC) + (size_t)sq * ML_NCH * 4096 + pi;
    unsigned* __restrict__ cs = (unsigned*)(ws + WS_CS) + (size_t)sq * ML_NCH * 4096 + pi;
    const float* __restrict__ dn = (const float*)(ws + WS_SM + SM_DN) + (size_t)sq * ML_NCH * 64 + pi;
    float* __restrict__ nst = (float*)(ws + WS_SM + SM_NST) + (size_t)sq * ML_NCH * 64 + pi;
    float* __restrict__ mst = (float*)(ws + WS_SM + SM_MST) + (size_t)sq * ML_NCH;
    float c0 = 0.f, c1 = 0.f, n = 0.f;
    for (int cb = 0; cb < ML_NCH; cb += 17) {
        unsigned dv[17]; float dnv[17];
#pragma unroll
        for (int q = 0; q < 17; ++q) { dv[q] = dc[(size_t)(cb + q) * 4096]; dnv[q] = (pi < 64) ? dn[(size_t)(cb + q) * 64] : 0.f; }
#pragma unroll
        for (int q = 0; q < 17; ++q) {
            const int ci = cb + q;
            cs[(size_t)ci * 4096] = pk2(c0, c1);
            if (pi < 64) nst[(size_t)ci * 64] = n;
            if (pi == 0) mst[ci] = sM[ci];
            const float aa = sA[ci], bb = sB[ci];
            c0 = aa * c0 + bb * bflo(dv[q]); c1 = aa * c1 + bb * bfhi(dv[q]); n = aa * n + bb * dnv[q];
        }
    }
    __syncthreads();
}
DI void mlC_phase(char* lds, const bf16_t* P, unsigned char* ws, bf16_t* HD0, bf16_t* HD1) {
    constexpr int STR = 144;
    char* Qs = lds; char* Ks = lds + 9216; char* VTs = lds + 27648; char* CTs = lds + 46080;
    float* tab = (float*)(lds + 64512); float* tu = tab; float* tM = tab + 64; float* tbc = tab + 128; float* tain = tab + 192; float* qn = tab + 320;
    int tid = threadIdx.x; asm volatile("" : "+v"(tid));
    const int w = tid >> 6, lane = tid & 63, r = lane & 31, h = lane >> 5, eb = w >> 1, xb = w & 1;
    const int srow = tid >> 3, sch = tid & 7, G = gridDim.x;
    u32x4 rq, rk, rv0, rv1, cs0, cs1; f32x4 n0, n1; float m_state = 0.f, gu = 0.f, gbc = 0.f, gam = 0.f;
#define MLC_LOAD(item) do { const int sq_ = (item) / ML_NCH, ci_ = (item) % ML_NCH, dir = sq_ & 1, hh_ = (sq_ >> 1) & 3, bl = sq_ >> 3; \
        const bf16_t* pr = P + (size_t)ML_ROW(ci_, srow) * NP; \
        rq = *(const u32x4*)(pr + PC_MLQ + hh_ * 64 + sch * 8); rk = *(const u32x4*)(pr + PC_MLK + hh_ * 64 + sch * 8); \
        rv0 = *(const u32x4*)(pr + PC_MLV + hh_ * 128 + sch * 8); rv1 = *(const u32x4*)(pr + PC_MLV + hh_ * 128 + 64 + sch * 8); \
        const u32x4* csp = (const u32x4*)((const bf16_t*)(ws + WS_CS) + (size_t)(item) * 8192); cs0 = csp[tid]; cs1 = csp[tid + 512]; \
        const float* nstp = (const float*)(ws + WS_SM + SM_NST) + (size_t)(item) * 64 + sch * 8; n0 = *(const f32x4*)nstp; n1 = *(const f32x4*)(nstp + 4); \
        m_state = ((const float*)(ws + WS_SM + SM_MST))[item]; \
        if (w == 0) { const float* tb = (const float*)(ws + WS_SM + SM_TAB) + (size_t)(item) * 192; gu = tb[lane]; gbc = tb[64 + lane]; gam = tb[128 + lane]; } } while (0)
    int item = blockIdx.x;
    if (item < ML_ITEMS) MLC_LOAD(item);
    for (; item < ML_ITEMS; item += G) {
        const int sq = item / ML_NCH, ci = item % ML_NCH, dir = sq & 1, hh = (sq >> 1) & 3, bl = sq >> 3;
        bf16_t* HD = dir ? HD1 : HD0;
        if (w == 0) { const float Mt = fmaxf(m_state, gam); tu[lane] = gu; tM[lane] = Mt; tbc[lane] = gbc; tain[lane] = __expf(m_state - Mt); }
        float qv[8];
        { const unsigned qw[4] = {rq.x, rq.y, rq.z, rq.w};
#pragma unroll
          for (int i = 0; i < 4; ++i) { qv[2 * i] = bflo(qw[i]) * 0.125f; qv[2 * i + 1] = bfhi(qw[i]) * 0.125f; } }
        { u32x4 qs; qs.x = pk2(qv[0], qv[1]); qs.y = pk2(qv[2], qv[3]); qs.z = pk2(qv[4], qv[5]); qs.w = pk2(qv[6], qv[7]);
          *(u32x4*)(Qs + srow * STR + sch * 16) = qs; *(u32x4*)(Ks + srow * STR + sch * 16) = rk; }
        { const unsigned vw[8] = {rv0.x, rv0.y, rv0.z, rv0.w, rv1.x, rv1.y, rv1.z, rv1.w};
#pragma unroll
          for (int i = 0; i < 8; ++i) { const int e = (i < 4 ? 0 : 64) + sch * 8 + 2 * (i & 3);
              *(bf16_t*)(VTs + e * STR + srow * 2) = (bf16_t)(vw[i] & 0xffffu); *(bf16_t*)(VTs + (e + 1) * STR + srow * 2) = (bf16_t)(vw[i] >> 16); } }
        *(u32x4*)(CTs + (tid >> 3) * STR + (tid & 7) * 16) = cs0; *(u32x4*)(CTs + (64 + (tid >> 3)) * STR + (tid & 7) * 16) = cs1;
        { float sm = qv[0] * n0[0] + qv[1] * n0[1] + qv[2] * n0[2] + qv[3] * n0[3] + qv[4] * n1[0] + qv[5] * n1[1] + qv[6] * n1[2] + qv[7] * n1[3];
          sm += shx(sm, lane, 1); sm += shx(sm, lane, 2); sm += shx(sm, lane, 4);
          if (sch == 0) qn[srow] = sm; }
        if (item + G < ML_ITEMS) MLC_LOAD(item + G);
        __syncthreads();
        {
            const int t = 32 * xb + r;
            f32x16 X0, X1, Y;
#pragma unroll
            for (int i = 0; i < 16; ++i) { X0[i] = 0.f; X1[i] = 0.f; Y[i] = 0.f; }
#pragma unroll
            for (int st = 0; st < 4; ++st) {
                const bf16x8 qB = *(const bf16x8*)(Qs + t * STR + (16 * st + 8 * h) * 2);
                const bf16x8 k0 = *(const bf16x8*)(Ks + r * STR + (16 * st + 8 * h) * 2), k1 = *(const bf16x8*)(Ks + (32 + r) * STR + (16 * st + 8 * h) * 2);
                const bf16x8 cA = *(const bf16x8*)(CTs + (32 * eb + r) * STR + (16 * st + 8 * h) * 2);
                X0 = MFMA32(k0, qB, X0); X1 = MFMA32(k1, qB, X1); Y = MFMA32(cA, qB, Y);
            }
            const float Mtt = tM[t], ai = tain[t];
            float dsum = 0.f;
#pragma unroll
            for (int i = 0; i < 16; ++i) {
                const int s0 = crow(i, h), s1 = 32 + s0;
                X0[i] = (s0 <= t) ? X0[i] * __expf(tu[s0] - Mtt) : 0.f;
                X1[i] = (s1 <= t) ? X1[i] * __expf(tu[s1] - Mtt) : 0.f;
                dsum += X0[i] + X1[i]; Y[i] *= ai;
            }
            dsum += shx(dsum, lane, 32);
#pragma unroll
            for (int sb = 0; sb < 2; ++sb)
#pragma unroll
                for (int s2 = 0; s2 < 2; ++s2) {
                    const bf16x8 pf = pack8(sb ? X1 : X0, s2);
                    const char* vb = VTs + (32 * eb + r) * STR + (32 * sb + 16 * s2 + 4 * h) * 2;
                    const u32x2 lo = *(const u32x2*)vb, hi = *(const u32x2*)(vb + 16);
                    Y = MFMA32(__builtin_bit_cast(bf16x8, (u32x4){lo.x, lo.y, hi.x, hi.y}), pf, Y);
                }
            const float den = ai * qn[t] + dsum;
            const float inv = 1.f / fmaxf(fabsf(den), __expf(-(tbc[t] + Mtt)));
            bf16_t* op = HD + (size_t)ML_ROW(ci, t) * 512 + hh * 128 + 32 * eb + 4 * h;
#pragma unroll
            for (int i4 = 0; i4 < 4; ++i4) { u32x2 wv; wv.x = pk2(Y[4 * i4] * inv, Y[4 * i4 + 1] * inv); wv.y = pk2(Y[4 * i4 + 2] * inv, Y[4 * i4 + 3] * inv); *(u32x2*)(op + 8 * i4) = wv; }
        }
        __syncthreads();
    }
#undef MLC_LOAD
}

DI int mx_take(volatile int* s_item, unsigned* ctr) {
    if (threadIdx.x == 0) *s_item = (int)atomicAdd(ctr, 1u);
    __syncthreads();
    const int it = *s_item;
    __syncthreads();
    return it;
}
DI void mixer_phase(char* lds, KArgs a, int l, bool want_ctx, unsigned* ctr, unsigned char* ws, bf16_t* P, const bf16_t* Qb, const bf16_t* Qc, const bf16_t* Kb, const bf16_t* Vb, bf16_t* HD0, bf16_t* HD1) {
    volatile int* s_item = (volatile int*)(lds + 140000);
    const int x = (int)(xb_xcc_id() & 7u);
    { float Cmla, Cna; bool fix; int tx_ = threadIdx.x; asm volatile("" : "+v"(tx_)); const int lane = tx_ & 63;
      float gq = 0.f, gk = 0.f, nq = 0.f, nk = 0.f, rb = 0.f;
      for (int i = lane; i < 96; i += 64) { gq = fmaxf(gq, fabsf(a->in[17][l * 96 + i])); gk = fmaxf(gk, fabsf(a->in[18][l * 96 + i])); }
      nq = fabsf(a->in[20][l * 64 + lane]); nk = fabsf(a->in[21][l * 64 + lane]);
      for (int i = lane; i < 8 * 465; i += 64) rb = fmaxf(rb, fabsf(a->in[22][(size_t)l * 8 * 465 + i]));
#pragma unroll
      for (int o = 32; o >= 1; o >>= 1) { gq = fmaxf(gq, shx(gq, lane, o)); gk = fmaxf(gk, shx(gk, lane, o)); nq = fmaxf(nq, shx(nq, lane, o)); nk = fmaxf(nk, shx(nk, lane, o)); rb = fmaxf(rb, shx(rb, lane, o)); }
      Cmla = 9.79796f * gq * gk * LOG2E * 1.02f + 0.05f;
      Cna = (8.f * nq * nk * 1.02f + rb) * LOG2E + 0.05f;
      fix = (Cmla < 40.f) && (Cna < 40.f) && (Cmla == Cmla) && (Cna == Cna);
      volatile float* sc_ = (volatile float*)(lds + 140048);
      if (threadIdx.x == 0) { sc_[0] = Cmla; sc_[1] = Cna; sc_[2] = fix ? 1.f : 0.f; }
      __syncthreads(); }
#define MX_CMLA (((volatile float*)(lds + 140048))[0])
#define MX_CNA (((volatile float*)(lds + 140048))[1])
#define MX_FIX ((((volatile float*)(lds + 140048))[2]) != 0.f)
    const int nq = want_ctx ? 136 : 128;
    for (int k = 0; k < 8; ++k) {
        const int q = (x + k) & 7;
        for (;;) {
            const int i = mx_take(s_item, ctr + 1 + q);
            if (i >= nq) break;
            const bool fix = MX_FIX;
            AttnP p{};
            if (i < 64 || (i >= 128 && i < 132)) {
                if (i < 64) { const int bh = q + 8 * (i >> 4), qt = i & 15, bl = bh >> 3, hh = bh & 7;
                    p.Q = Qb + ((size_t)bh * SEQ + qt * 256) * 96; p.ntiles = 68; p.O = P + (size_t)(bl * SEQ + qt * 256) * NP + PC_AMLA + hh * 64;
                    p.Kb = Kb + (size_t)bh * TALL * 96; p.Vb = Vb + (size_t)bh * TALL * 64; }
                else { const int bh = q + 8 * (i - 128), bl = bh >> 3, hh = bh & 7;
                    p.Q = Qc + (size_t)bh * CTXL * 96; p.ntiles = 4; p.O = P + (size_t)(MG_LAT + bl * CTXL) * NP + PC_AMLA + hh * 64;
                    p.Kb = Kb + (size_t)bh * TALL * 96; p.Vb = Vb + (size_t)bh * TALL * 64; }
                p.q_ld = 96; p.o_ld = NP; p.C = MX_CMLA;
                if (fix) attn_unit<0, true>(lds, p); else attn_unit<0, false>(lds, p);
            } else {
                p.q_ld = NP; p.o_ld = NP; p.C = MX_CNA;
                if (i < 128) { const int u = i - 64, bh = q + 8 * (u >> 4), rb = u & 15, bl = bh >> 3, hh = bh & 7, r0 = rb * 4;
                    p.Q = P + (size_t)(bl * SEQ + r0 * 64) * NP + PC_NAQ + hh * 64; p.O = P + (size_t)(bl * SEQ + r0 * 64) * NP + PC_NAQ + hh * 64; p.r0 = r0;
                    p.rlo = min(max(r0 - 4, 0), 56); const int rhi = min(max(r0 + 3 - 4, 0), 56) + 7; p.nb = rhi - p.rlo + 1; p.ntiles = p.nb + 4;
                    p.Kb = P + (size_t)(bl * SEQ) * NP + PC_NAK + hh * 64; p.Vb = P + (size_t)(bl * SEQ) * NP + PC_NAV + hh * 64;
                    p.Kc = P + (size_t)(MG_LAT + bl * CTXL) * NP + PC_NAK + hh * 64; p.Vc = P + (size_t)(MG_LAT + bl * CTXL) * NP + PC_NAV + hh * 64;
                    p.rpb = a->in[22] + (size_t)(l * 8 + hh) * 465; }
                else { const int bh = q + 8 * (i - 132), bl = bh >> 3, hh = bh & 7;
                    p.Q = P + (size_t)(MG_LAT + bl * CTXL) * NP + PC_NAQ + hh * 64; p.O = P + (size_t)(MG_LAT + bl * CTXL) * NP + PC_NAQ + hh * 64;
                    p.r0 = 0; p.rlo = 0; p.nb = 0; p.ntiles = 4;
                    p.Kc = P + (size_t)(MG_LAT + bl * CTXL) * NP + PC_NAK + hh * 64; p.Vc = P + (size_t)(MG_LAT + bl * CTXL) * NP + PC_NAV + hh * 64;
                    p.Kb = p.Kc; p.Vb = p.Vc; p.rpb = a->in[22] + (size_t)(l * 8 + hh) * 465; }
                if (fix) attn_unit<1, true>(lds, p); else attn_unit<1, false>(lds, p);
            }
        }
    }
    mlC_phase(lds, P, ws, HD0, HD1);
}

__global__ void __launch_bounds__(512, 2) fwd_kernel(Args a_unused) {
    KArgs a = (KArgs)__builtin_amdgcn_kernarg_segment_ptr();
    extern __shared__ __attribute__((aligned(16))) unsigned char lds_raw[];
    cg::grid_group grid = cg::this_grid();
    char* lds = (char*)lds_raw;
    LAS unsigned char* ldsl = (LAS unsigned char*)lds_raw;
    const int G = gridDim.x, bid = blockIdx.x;
    { volatile LAS unsigned* st0 = (volatile LAS unsigned*)(lds_raw + 140032); if (threadIdx.x == 0) { st0[0] = 0u; st0[1] = 0u; } }
    __syncthreads();
    const XcdBarrier xbar = xcd_barrier_post((unsigned*)(a->ws + WS_CTL) + 4096, (volatile LAS unsigned*)(lds_raw + 140032));
#define GSYNC() xcd_barrier(xbar)
    unsigned char* ws = a->ws;
#define mod ((float*)(ws + WS_MOD))
#define xctx ((float*)(ws + WS_XCTX))
#define Hb ((bf16_t*)(ws + WS_H))
#define P ((bf16_t*)(ws + WS_P))
#define H2 ((bf16_t*)(ws + WS_H2))
#define U ((bf16_t*)(ws + WS_U))
#define Tb ((bf16_t*)(ws + WS_T))
#define Qb ((bf16_t*)(ws + WS_Q))
#define Qcb ((bf16_t*)(ws + WS_QC))
#define Kb ((bf16_t*)(ws + WS_K))
#define Vb ((bf16_t*)(ws + WS_V))
#define HD0 ((bf16_t*)(ws + WS_HD0))
#define HD1 ((bf16_t*)(ws + WS_HD1))
    if (bid < 192) mod_item(lds, a, bid);
    if (bid == 255 || (G < 256 && bid == 0)) { for (int i = threadIdx.x; i < 512; i += 512) { const int pos = i >> 3, f = i & 7; float sn, cs; sincosf((float)pos * expf(-(float)f * 0.125f * 9.210340371976184f), &sn, &cs);
        float* rt = (float*)(ws + WS_ROPE); rt[2 * i] = cs; rt[2 * i + 1] = sn; } }
    wconv_range(lds, a, bid, WT_LAYER, G);
    grid.sync();

#pragma unroll 1
    for (int l = 0; l < DEPTH; ++l) {
        asm volatile("" : "+s"(ws));
        const bool want_ctx = (l < DEPTH - 1);
#define modl (mod + (size_t)l * 9 * 6 * D)
#define wb (ws + WS_W + (size_t)l * W_LAYER)
#define xin_lat ((l == 0) ? a->in[0] : (const float*)a->out)
#define xin_ctx ((l == 0) ? a->in[2] : (const float*)xctx)
#pragma unroll 1
        for (int g = 0; g < NGROUP; ++g) {
            asm volatile("" : "+s"(ws));
            norm_phase(xin_lat, xin_ctx, MG_LAT, MG, g * MG_LAT, g * MG_CTX, a->in[6] + l * D, modl, 0, D, Hb);
            GSYNC();
            if (want_ctx) { pg8::Gemm gm{Hb, D, (const bf16_t*)(wb + WO_IN), MG, NP, D}; pg8::StaticOrder S; S.init(MG, NP, G, bid);
              pg8::EpiStore E{P, NP, 0}; pg8::gemm_phase(ldsl, gm, S, E); }
            else { pg8::Gemm gm{Hb, D, (const bf16_t*)(wb + WO_IN), MG, NP, D}; pg8::CtxSkipOrder S; S.init(G, bid);
              pg8::EpiStore E{P, NP, 0}; pg8::gemm_phase(ldsl, gm, S, E); }
            if (l == 0 && bid >= 44) wconv_range(lds, a, WT_LAYER + g * (WT_LAYER / 2) + (bid - 44), WT_LAYER + (g + 1) * (WT_LAYER / 2), G - 44);
            GSYNC();
            { pg8::SplitOrder S; S.init(MG, TW, G, bid, 3); pg8::Gemm gm{P + PC_DQ, NP, (const bf16_t*)(wb + WO_UQ), MG, TW, 384, PC_DKV - PC_DQ, 0, 0};
              pg8::EpiStore E{Tb, TW, 0}; pg8::gemm_phase(ldsl, gm, S, E); }
            mlA_phase(lds, a, l, P, ws);
            GSYNC();
            prep_phase(a, l, want_ctx, P, Tb, Qb, Qcb, Kb, Vb, (const float*)(ws + WS_ROPE));
            mlB_phase(lds, ws);
            GSYNC();
            mixer_phase(lds, a, l, want_ctx, (unsigned*)(ws + WS_CTL) + (l * NGROUP + g) * 16, ws, P, Qb, Qcb, Kb, Vb, HD0, HD1);
            GSYNC();
            const int mrows = want_ctx ? MG : MG_LAT;
            mlcomb_phase(a, l, mrows, P, HD0, HD1);
            GSYNC();
            { pg8::MergeOrder S; S.init(mrows, D, G, bid);
              pg8::Gemm gm{P + PC_MLO, NP, (const bf16_t*)(wb + WO_MLWO), mrows, D, 512, PC_AMLA - PC_MLO, PC_NAQ - PC_MLO, D * 512};
              pg8::EpiMerge E{P}; pg8::gemm_phase(ldsl, gm, S, E); }
            GSYNC();
            { pg8::Gemm gm{P + PC_Z, NP, (const bf16_t*)(wb + WO_WOUT), mrows, D, D}; pg8::StaticOrder S; S.init(mrows, D, G, bid);
              pg8::EpiRes E{xin_lat, xin_ctx, a->out, xctx, modl, 2 * D, MG_LAT, g * MG_LAT, g * MG_CTX}; pg8::gemm_phase(ldsl, gm, S, E); }
            GSYNC();
        }
        const int frows = want_ctx ? M_ALL : M_LAT;
        norm_phase(a->out, xctx, M_LAT, frows, 0, 0, a->in[7] + l * D, modl, 3 * D, 4 * D, H2);
        GSYNC();
        { pg8::Gemm gm{H2, D, (const bf16_t*)(wb + WO_FF1), frows, DFF, D}; pg8::StaticOrder S; S.init(frows, DFF, G, bid);
          pg8::EpiStore E{U, DFF, 1}; pg8::gemm_phase(ldsl, gm, S, E); }
        GSYNC();
        { pg8::Gemm gm{U, DFF, (const bf16_t*)(wb + WO_FF2), frows, D, DFF}; pg8::StaticOrder S; S.init(frows, D, G, bid);
          pg8::EpiRes E{a->out, xctx, a->out, xctx, modl, 5 * D, M_LAT, 0, 0}; pg8::gemm_phase(ldsl, gm, S, E); }
        GSYNC();
    }
}

extern "C" void kernel_launch(void* const* d_in, const int* in_sizes, int n_in, void* d_out, int out_size, void* d_ws, size_t ws_size, hipStream_t stream) {
    static int grid = 0;
    if (grid == 0) {
        if (n_in != 27 || in_sizes[0] != M_LAT * D || out_size != M_LAT * D || ws_size < 512 * MiB) {
            fprintf(stderr, "kernel_launch: unexpected shapes (n_in %d, in0 %d, out %d, ws %zu); nothing launched\n", n_in, n_in > 0 ? in_sizes[0] : -1, out_size, ws_size); grid = -1; return; }
        int dev = 0, cus = 0, per_cu = 0;
        hipGetDevice(&dev); hipDeviceGetAttribute(&cus, hipDeviceAttributeMultiprocessorCount, dev);
        if (hipFuncSetAttribute((const void*)fwd_kernel, hipFuncAttributeMaxDynamicSharedMemorySize, LDS_BYTES) != hipSuccess) { fprintf(stderr, "hipFuncSetAttribute failed\n"); grid = -1; return; }
        hipOccupancyMaxActiveBlocksPerMultiprocessor(&per_cu, (const void*)fwd_kernel, 512, LDS_BYTES);
        if (per_cu < 1) { fprintf(stderr, "occupancy query says %d blocks/CU\n", per_cu); per_cu = 1; }
        (void)hipGetLastError();
        grid = cus;
    }
    if (grid < 0) return;
    (void)hipMemsetAsync((char*)d_ws + WS_CTL, 0, 65536, stream);
    Args a{};
    for (int i = 0; i < 27; ++i) a.in[i] = (const float*)d_in[i];
    a.out = (float*)d_out; a.ws = (unsigned char*)d_ws;
    void* args[] = {&a};
    hipError_t e = hipLaunchCooperativeKernel((const void*)fwd_kernel, dim3(grid), dim3(512), args, LDS_BYTES, stream);
    if (e != hipSuccess) fprintf(stderr, "cooperative launch failed: %s (grid %d)\n", hipGetErrorString(e), grid);
}
```

```cpp
#include <hip/hip_runtime.h>
#include <hip/hip_cooperative_groups.h>
#include <cstdio>
#include <cstdint>
namespace cg = cooperative_groups;

#define DI __device__ __forceinline__
#define LAS __attribute__((address_space(3)))
typedef unsigned short bf16_t;
typedef short bf16x8 __attribute__((ext_vector_type(8)));
typedef float f32x4 __attribute__((ext_vector_type(4)));
typedef float f32x16 __attribute__((ext_vector_type(16)));
typedef float f32x2_t __attribute__((ext_vector_type(2)));
typedef __bf16 bf16x2_t __attribute__((ext_vector_type(2)));
typedef unsigned u32x4 __attribute__((ext_vector_type(4)));
typedef unsigned u32x2 __attribute__((ext_vector_type(2)));

constexpr int D = 1024, NBATCH = 8, SEQ = 4096, CTXL = 256, DFF = 4096, DEPTH = 2;
constexpr int GB = 4, NGROUP = 2;
constexpr int MG_LAT = GB * SEQ, MG_CTX = GB * CTXL, MG = MG_LAT + MG_CTX;
constexpr int M_LAT = NBATCH * SEQ, M_CTX = NBATCH * CTXL, M_ALL = M_LAT + M_CTX;
constexpr int D_IN = 6832, NP = 6912;
constexpr int TALL = CTXL + SEQ;
constexpr int PC_MLQ = 0, PC_MLK = 256, PC_MLV = 512, PC_MLO = 1024, PC_NAQ = 1536, PC_NAK = 2048, PC_NAV = 2560,
              PC_DQ = 3072, PC_DKV = 3456, PC_KR = 3712, PC_GT = 3744, PC_MG = 3840;
constexpr int PC_AMLA = 3072, PC_Z = 2048;
constexpr int TW = 1792;
constexpr float EPS = 1e-6f;
constexpr float LOG2E = 1.4426950408889634f;

constexpr size_t MiB = 1u << 20;
constexpr size_t WS_CTL = 0, WS_ROPE = 512 * 1024, WS_MOD = 1 * MiB, WS_W = 2 * MiB, W_LAYER = 36 * MiB;
constexpr size_t WO_IN = 0, WO_MLWO = 13 * MiB + 512 * 1024, WO_MLAWO = WO_MLWO + 1 * MiB, WO_NAWO = WO_MLAWO + 1 * MiB, WO_UQ = WO_NAWO + 1 * MiB, WO_UKV = WO_UQ + 576 * 1024,
                 WO_WOUT = WO_UKV + 768 * 1024, WO_FF1 = WO_WOUT + 2 * MiB, WO_FF2 = WO_FF1 + 8 * MiB;
static_assert(WO_FF2 + 8 * MiB <= W_LAYER, "weights");
constexpr size_t WS_XCTX = 74 * MiB, WS_QC = 82 * MiB, WS_REG = 84 * MiB;
constexpr size_t WS_H = WS_REG, WS_P = 118 * MiB, WS_Q = 348 * MiB, WS_K = 372 * MiB, WS_V = 398 * MiB, WS_HD0 = 415 * MiB, WS_HD1 = 432 * MiB, WS_T = 415 * MiB;
constexpr size_t WS_ANA = 450 * MiB;
constexpr size_t WS_H2 = WS_REG, WS_U = 152 * MiB;
constexpr size_t WS_END = 511 * MiB;
static_assert(WS_P + (size_t)MG * NP * 2 <= WS_Q && WS_T + (size_t)MG * TW * 2 <= WS_END && WS_U + (size_t)M_ALL * DFF * 2 <= WS_END, "ws map");

constexpr int LDS_BYTES = 147456;

DI unsigned pk2(float lo, float hi) { f32x2_t v = {lo, hi}; bf16x2_t b = __builtin_convertvector(v, bf16x2_t); return __builtin_bit_cast(unsigned, b); }
DI bf16_t f2bf(float f) { return (bf16_t)(pk2(f, 0.f) & 0xffffu); }
DI float bf2f(bf16_t v) { return __uint_as_float(((unsigned)v) << 16); }
DI float bflo(unsigned w) { return __uint_as_float(w << 16); }
DI float bfhi(unsigned w) { return __uint_as_float(w & 0xffff0000u); }
template <int CTRL> DI float dpp_f(float v) { return __int_as_float(__builtin_amdgcn_update_dpp(0, __float_as_int(v), CTRL, 0xF, 0xF, true)); }
DI float sum4(float v) { v += dpp_f<0xB1>(v); v += dpp_f<0x4E>(v); return v; }
DI float sum8(float v) { v = sum4(v); v += dpp_f<0x141>(v); return v; }
DI float sum16(float v) { v = sum8(v); v += dpp_f<0x140>(v); return v; }
DI float wave_sum(float v) {
    v = sum16(v);
    const int iv = __float_as_int(v);
    return (__int_as_float(__builtin_amdgcn_readlane(iv, 0)) + __int_as_float(__builtin_amdgcn_readlane(iv, 16))) + (__int_as_float(__builtin_amdgcn_readlane(iv, 32)) + __int_as_float(__builtin_amdgcn_readlane(iv, 48)));
}
DI float shx(float v, int lane, int m) { return __int_as_float(__builtin_amdgcn_ds_bpermute((lane ^ m) << 2, __float_as_int(v))); }
DI float shu(float v, int lane, int d) { return __int_as_float(__builtin_amdgcn_ds_bpermute(((lane - d) & 63) << 2, __float_as_int(v))); }
DI float rdl63(float v) { return __int_as_float(__builtin_amdgcn_readlane(__float_as_int(v), 63)); }
DI float sigmoidf_(float x) { return __builtin_amdgcn_rcpf(1.f + __expf(-x)); }

namespace pg8 {
constexpr int BM = 256, BK = 64, HALF = 128, HTB = HALF * BK * 2, NXCD = 8, WGM = 8;
DI int lds_byte(int r, int c) { const int st = (r >> 4) * 2 + (c >> 5), rr = r & 15, cc = c & 31, ob = rr * 64 + cc * 2; return st * 1024 + (ob ^ (((ob >> 9) & 1) << 5)); }
DI void stage_rc(int b, int& R, int& C) { const int st = b / 1024, sb = b % 1024, swz = sb ^ (((sb >> 9) & 1) << 5); R = (st >> 1) * 16 + swz / 64; C = (st & 1) * 32 + (swz % 64) / 2; }
DI int perm32(int rho) { const int n = rho >> 4, i = rho & 15; return 8 * (i >> 2) + 4 * n + (i & 3); }
struct Unit { int pm, pn, br; };
struct Gemm { const bf16_t* A; int lda; const bf16_t* Bt; int M, N, K; int a1 = 0, a2 = 0; int bbr = 0; };
struct StaticOrder {
    int nM, nN, nwg, G, c;
    DI void init(int M, int N, int G_, int c_) { nM = M / BM; nN = N / BM; nwg = nM * nN; G = G_; c = c_; }
    DI bool next(int i, Unit& u) const {
        const long L = (long)i * G + c; if (L >= nwg) return false;
        int wgid = (int)L; { const int q = nwg / NXCD, r = nwg % NXCD, xcd = wgid % NXCD, off = wgid / NXCD; wgid = (xcd < r ? xcd * (q + 1) : r * (q + 1) + (xcd - r) * q) + off; }
        const int nig = WGM * nN, gid = wgid / nig, fm = gid * WGM, gsz = (nM - fm) < WGM ? (nM - fm) : WGM;
        u.pm = fm + ((wgid % nig) % gsz); u.pn = (wgid % nig) / gsz; u.br = 0; return true;
    }
    DI bool keep(const Unit&) const { return false; }
};
struct CtxSkipOrder {
    StaticOrder T; int G, c;
    DI void init(int G_, int c_) { T.init(MG_LAT, NP, G_, c_); G = G_; c = c_; }
    DI bool next(int i, Unit& u) const {
        const int L = i * G + c;
        if (L < 64 * 27) return T.next(i, u);
        const int x = L - 64 * 27; if (x >= 36) return false;
        const int q = x / 9, k = x - 9 * q;
        u.pm = 64 + q; u.pn = (k < 3) ? 1 + k : (k < 7 ? 5 + k : 6 + k); u.br = 0; return true;
    }
    DI bool keep(const Unit&) const { return false; }
};
struct SplitOrder {
    StaticOrder T; int split;
    DI void init(int M, int N, int G_, int c_, int split_) { T.init(M, N, G_, c_); split = split_; }
    DI bool next(int i, Unit& u) const { if (!T.next(i, u)) return false; u.br = (u.pn >= split) ? 1 : 0; return true; }
    DI bool keep(const Unit&) const { return false; }
};
struct MergeOrder {
    StaticOrder T;
    DI void init(int M, int N, int G_, int c_) { T.init(M, N, G_, c_); }
    DI bool next(int i, Unit& u) const { const int t = i / 3; if (!T.next(t, u)) return false; u.br = i - 3 * t; return true; }
    DI bool keep(const Unit& u) const { return u.br < 2; }
};
#define PG8_ABASE(u) ((const char*)g.A + (size_t)(u).pm * tstepA + (size_t)((u).br == 0 ? 0 : ((u).br == 1 ? g.a1 : g.a2)) * 2)
#define PG8_BBASE(u) ((const char*)g.Bt + (size_t)(u).pn * tstepB + (size_t)(u).br * g.bbr * 2)
template <class Epi, class Sched>
DI void gemm_phase(LAS unsigned char* lds, const Gemm g, const Sched& S, const Epi& E) {
    int tid = threadIdx.x; asm volatile("" : "+v"(tid));
    const int wid = __builtin_amdgcn_readfirstlane(tid >> 6), lane = tid & 63, wr = wid >> 2, wc = wid & 3, fr = lane & 15, fq = lane >> 4;
    const int K = g.K, nt = K / BK, lda = g.lda;
    unsigned voffA[2], voffB[2];
#pragma unroll
    for (int i = 0; i < 2; ++i) { int R, C; stage_rc(tid * 16 + i * 8192, R, C); const int Rb = (R & ~31) + perm32(R & 31);
        voffA[i] = (unsigned)(R * lda + C) * 2u; voffB[i] = (unsigned)(Rb * K + C) * 2u; }
    const size_t kstep = (size_t)(BK * 2);
    const size_t hstepA = (size_t)HALF * lda * 2, hstepB = (size_t)HALF * K * 2;
    const size_t tstepA = 2 * hstepA, tstepB = 2 * hstepB;
    const unsigned ldsw = (unsigned)wid * 1024u;
    const int aoff = lds_byte(wr * 64 + fr, fq * 8), boff = lds_byte(wc * 32 + fr, fq * 8);
#define PG8_SA(b, h) (((b) * 2 + (h)) * HTB)
#define PG8_SB(b, h) ((4 + (b) * 2 + (h)) * HTB)
#define PG8_STAGE(bufoff, gbase, voff) do { _Pragma("unroll") for (int _i = 0; _i < 2; ++_i) \
        __builtin_amdgcn_global_load_lds((const unsigned*)((const char*)(gbase) + (voff)[_i]), (LAS unsigned*)(lds + (bufoff) + ldsw + _i * 8192), 16, 0, 0); } while (0)
#define PG8_LDA(dst, b, h) do { _Pragma("unroll") for (int m = 0; m < 4; ++m) _Pragma("unroll") for (int k = 0; k < 2; ++k) dst[m][k] = *(const LAS bf16x8*)(lds + PG8_SA(b, h) + aoff + m * 2048 + k * 1024); } while (0)
#define PG8_LDB(dst, b, h) do { _Pragma("unroll") for (int n = 0; n < 2; ++n) _Pragma("unroll") for (int k = 0; k < 2; ++k) dst[n][k] = *(const LAS bf16x8*)(lds + PG8_SB(b, h) + boff + n * 2048 + k * 1024); } while (0)
#define PG8_MMA(ai, bj, At, Bt) do { __builtin_amdgcn_s_setprio(1); _Pragma("unroll") for (int m = 0; m < 4; ++m) _Pragma("unroll") for (int n = 0; n < 2; ++n) _Pragma("unroll") for (int k = 0; k < 2; ++k) \
        acc[ai][bj][m][n] = __builtin_amdgcn_mfma_f32_16x16x32_bf16(Bt[n][k], At[m][k], acc[ai][bj][m][n], 0, 0, 0); __builtin_amdgcn_s_setprio(0); } while (0)
#define PG8_WAIT_V(n) asm volatile("s_waitcnt vmcnt(" #n ")" ::: "memory")
#define PG8_WAIT_L(n) asm volatile("s_waitcnt lgkmcnt(" #n ")" ::: "memory")
#define PG8_BAR __builtin_amdgcn_s_barrier()
#define PG8_SCHED __builtin_amdgcn_sched_barrier(0)
    Unit cur, nxt; int ui = 0;
    if (!S.next(0, cur)) return;
    f32x4 acc[2][2][4][2];
#pragma unroll
    for (int a = 0; a < 2; ++a)
#pragma unroll
        for (int b = 0; b < 2; ++b)
#pragma unroll
            for (int m = 0; m < 4; ++m)
#pragma unroll
                for (int n = 0; n < 2; ++n) acc[a][b][m][n] = (f32x4){0.f, 0.f, 0.f, 0.f};
    bf16x8 At[4][2], B0[2][2], B1[2][2];
    const char* cA = PG8_ABASE(cur); const char* cB = PG8_BBASE(cur);
    PG8_STAGE(PG8_SB(0, 0), cB, voffB); PG8_STAGE(PG8_SB(0, 1), cB + hstepB, voffB); PG8_STAGE(PG8_SA(0, 0), cA, voffA); PG8_STAGE(PG8_SA(0, 1), cA + hstepA, voffA);
    if (wr == 1) PG8_BAR;
    PG8_WAIT_V(2); PG8_BAR;
    PG8_STAGE(PG8_SB(1, 0), cB + kstep, voffB); PG8_STAGE(PG8_SA(1, 0), cA + kstep, voffA); PG8_STAGE(PG8_SB(1, 1), cB + hstepB + kstep, voffB);
    PG8_WAIT_V(6); PG8_BAR;
    for (;;) {
        const bool has_next = S.next(ui + 1, nxt);
        const char* nA = has_next ? PG8_ABASE(nxt) : cA; const char* nB = has_next ? PG8_BBASE(nxt) : cB;
        for (int t = 0; t < nt; t += 2) {
            const bool last = (t == nt - 2);
            const char* a1 = cA + (size_t)(t + 1) * kstep;
            const char* a2 = last ? nA : cA + (size_t)(t + 2) * kstep; const char* b2 = last ? nB : cB + (size_t)(t + 2) * kstep;
            const char* a3 = a2 + kstep; const char* b3 = b2 + kstep;
            PG8_LDB(B0, 0, 0); PG8_LDB(B1, 0, 1); PG8_SCHED; PG8_LDA(At, 0, 0); PG8_STAGE(PG8_SA(1, 1), a1 + hstepA, voffA);
            PG8_WAIT_V(8); PG8_WAIT_L(0); PG8_BAR; PG8_MMA(0, 0, At, B0); PG8_MMA(0, 1, At, B1); PG8_BAR; PG8_SCHED;
            PG8_LDA(At, 0, 1); PG8_STAGE(PG8_SB(0, 0), b2, voffB); PG8_STAGE(PG8_SB(0, 1), b2 + hstepB, voffB); PG8_STAGE(PG8_SA(0, 0), a2, voffA);
            PG8_WAIT_V(8); PG8_WAIT_L(0); PG8_BAR; PG8_MMA(1, 0, At, B0); PG8_MMA(1, 1, At, B1); PG8_BAR; PG8_SCHED;
            PG8_LDB(B0, 1, 0); PG8_LDB(B1, 1, 1); PG8_SCHED; PG8_LDA(At, 1, 0); PG8_STAGE(PG8_SA(0, 1), a2 + hstepA, voffA);
            PG8_WAIT_V(8); PG8_WAIT_L(0); PG8_BAR; PG8_MMA(0, 0, At, B0); PG8_MMA(0, 1, At, B1); PG8_BAR; PG8_SCHED;
            PG8_LDA(At, 1, 1); PG8_STAGE(PG8_SB(1, 0), b3, voffB); PG8_STAGE(PG8_SB(1, 1), b3 + hstepB, voffB); PG8_STAGE(PG8_SA(1, 0), a3, voffA);
            PG8_WAIT_V(8); PG8_WAIT_L(0); PG8_BAR; PG8_MMA(1, 0, At, B0); PG8_MMA(1, 1, At, B1); PG8_BAR; PG8_SCHED;
        }
        if (wr == 0) PG8_BAR;
        { int t2 = threadIdx.x; asm volatile("" : "+v"(t2)); E(acc, cur, wr, wc, t2 & 15, (t2 & 63) >> 4); }
        if (!has_next) break;
        if (!S.keep(cur)) {
#pragma unroll
        for (int a = 0; a < 2; ++a)
#pragma unroll
            for (int b = 0; b < 2; ++b)
#pragma unroll
                for (int m = 0; m < 4; ++m)
#pragma unroll
                    for (int n = 0; n < 2; ++n) acc[a][b][m][n] = (f32x4){0.f, 0.f, 0.f, 0.f};
        }
        cur = nxt; cA = nA; cB = nB; ++ui;
        if (wr == 1) PG8_BAR;
    }
    PG8_WAIT_V(0);
    PG8_BAR;
#undef PG8_SA
#undef PG8_SB
#undef PG8_STAGE
#undef PG8_LDA
#undef PG8_LDB
#undef PG8_MMA
#undef PG8_WAIT_V
#undef PG8_WAIT_L
#undef PG8_BAR
#undef PG8_SCHED
}

struct EpiStore {
    bf16_t* O; int ldc; int act;
    DI void operator()(const f32x4 (&acc)[2][2][4][2], const Unit& u, int wr, int wc, int fr, int fq) const {
        const int row0 = u.pm * BM + wr * 64 + fr, col0 = u.pn * BM + wc * 32 + 8 * fq;
#pragma unroll
        for (int ai = 0; ai < 2; ++ai)
#pragma unroll
            for (int m = 0; m < 4; ++m) { bf16_t* rowp = O + (size_t)(row0 + ai * HALF + m * 16) * ldc + col0;
#pragma unroll
                for (int bj = 0; bj < 2; ++bj) { f32x4 v0 = acc[ai][bj][m][0], v1 = acc[ai][bj][m][1];
                    if (act == 1) {
#pragma unroll
                        for (int j = 0; j < 4; ++j) { float a = fmaxf(v0[j], 0.f), b = fmaxf(v1[j], 0.f); v0[j] = a * a; v1[j] = b * b; } }
                    u32x4 w; w.x = pk2(v0[0], v0[1]); w.y = pk2(v0[2], v0[3]); w.z = pk2(v1[0], v1[1]); w.w = pk2(v1[2], v1[3]);
                    *(u32x4*)(rowp + bj * HALF) = w; } }
    }
};
struct EpiMerge {
    bf16_t* P;
    DI void operator()(f32x4 (&acc)[2][2][4][2], const Unit& u, int wr, int wc, int fr, int fq) const {
        const int row0 = u.pm * BM + wr * 64 + fr, col0 = u.pn * BM + wc * 32 + 8 * fq;
        const int gc = PC_MG + u.br * D;
#pragma unroll
        for (int ai = 0; ai < 2; ++ai)
#pragma unroll
            for (int m = 0; m < 4; ++m) { bf16_t* rowp = P + (size_t)(row0 + ai * HALF + m * 16) * NP;
#pragma unroll
                for (int bj = 0; bj < 2; ++bj) { const int c = col0 + bj * HALF;
                    const u32x4 ga = *(const u32x4*)(rowp + gc + c);
                    float xa[8]; xa[0] = bflo(ga.x); xa[1] = bfhi(ga.x); xa[2] = bflo(ga.y); xa[3] = bfhi(ga.y); xa[4] = bflo(ga.z); xa[5] = bfhi(ga.z); xa[6] = bflo(ga.w); xa[7] = bfhi(ga.w);
                    f32x4& v0 = acc[ai][bj][m][0]; f32x4& v1 = acc[ai][bj][m][1];
                    if (u.br < 2) {
                        const u32x4 gb = *(const u32x4*)(rowp + gc + D + c);
                        float xb[8]; xb[0] = bflo(gb.x); xb[1] = bfhi(gb.x); xb[2] = bflo(gb.y); xb[3] = bfhi(gb.y); xb[4] = bflo(gb.z); xb[5] = bfhi(gb.z); xb[6] = bflo(gb.w); xb[7] = bfhi(gb.w);
#pragma unroll
                        for (int j = 0; j < 4; ++j) { v0[j] *= (1.f + __expf(-xb[j])) * __builtin_amdgcn_rcpf(1.f + __expf(-xa[j])); v1[j] *= (1.f + __expf(-xb[4 + j])) * __builtin_amdgcn_rcpf(1.f + __expf(-xa[4 + j])); }
                    } else {
                        u32x4 w; w.x = pk2(v0[0] * sigmoidf_(xa[0]), v0[1] * sigmoidf_(xa[1])); w.y = pk2(v0[2] * sigmoidf_(xa[2]), v0[3] * sigmoidf_(xa[3]));
                        w.z = pk2(v1[0] * sigmoidf_(xa[4]), v1[1] * sigmoidf_(xa[5])); w.w = pk2(v1[2] * sigmoidf_(xa[6]), v1[3] * sigmoidf_(xa[7]));
                        *(u32x4*)(rowp + PC_Z + c) = w;
                    } } }
    }
};
struct EpiRes {
    const float* src_lat; const float* src_ctx; float* dst_lat; float* dst_ctx; const float* modl; int goff; int nlat, latoff, ctxoff;
    DI void operator()(const f32x4 (&acc)[2][2][4][2], const Unit& u, int wr, int wc, int fr, int fq) const {
        const int row0 = u.pm * BM + wr * 64 + fr, col0 = u.pn * BM + wc * 32 + 8 * fq;
        const int trow = u.pm * BM;
        const bool lat = trow < nlat;
        const int b = lat ? (latoff + trow) / SEQ : NBATCH;
        const float* gate = modl + (size_t)b * 6 * D + goff;
        const float* sb = lat ? src_lat + (long)latoff * D : src_ctx + ((long)ctxoff - nlat) * D;
        float* db = lat ? dst_lat + (long)latoff * D : dst_ctx + ((long)ctxoff - nlat) * D;
        f32x4 gv[2][2];
#pragma unroll
        for (int bj = 0; bj < 2; ++bj)
#pragma unroll
            for (int n = 0; n < 2; ++n) gv[bj][n] = *(const f32x4*)(gate + col0 + bj * HALF + 4 * n);
#pragma unroll
        for (int ai = 0; ai < 2; ++ai)
#pragma unroll
            for (int m = 0; m < 4; ++m) { const size_t ro = (size_t)(row0 + ai * HALF + m * 16) * D + col0;
#pragma unroll
                for (int bj = 0; bj < 2; ++bj)
#pragma unroll
                    for (int n = 0; n < 2; ++n) { const f32x4 s = *(const f32x4*)(sb + ro + bj * HALF + 4 * n);
                        *(f32x4*)(db + ro + bj * HALF + 4 * n) = s + gv[bj][n] * acc[ai][bj][m][n]; } }
    }
};
}


#define XB_TMO      128
#define XB_XCNT(j)  (256  + 64 * (j))
#define XB_XSUB(j)  (1280 + 64 * (j))
#define XB_XGEN(j)  (2304 + 64 * (j))
#define XB_TOP      3328
#define XB_TOPGEN   3392
#define XCD_BAR_WORDS 3456
#define XB_SPIN_CAP (1u << 22)
DI unsigned xb_ld(unsigned* p)              { return __hip_atomic_load(p, __ATOMIC_RELAXED, __HIP_MEMORY_SCOPE_AGENT); }
DI unsigned xb_add(unsigned* p, unsigned v) { return __hip_atomic_fetch_add(p, v, __ATOMIC_RELAXED, __HIP_MEMORY_SCOPE_AGENT); }
DI unsigned xb_xcc_id() { return (unsigned)__builtin_amdgcn_s_getreg((3 << 11) | 20) & 0xFu; }
#define XB_SPIN(cond, bar) do { unsigned _sp = 0; while (cond) { \
    if ((++_sp & 255u) == 0u) { if (xb_ld(&(bar)[XB_TMO])) break; if (_sp > XB_SPIN_CAP) { atomicAdd(&(bar)[XB_TMO], 1u); break; } } } } while (0)
struct XcdBarrier { unsigned* bar; unsigned x; volatile LAS unsigned* st; };
DI XcdBarrier xcd_barrier_post(unsigned* bar, volatile LAS unsigned* st) {
    XcdBarrier b; b.bar = bar; b.x = xb_xcc_id(); b.st = st;
    if (threadIdx.x == 0) (void)xb_add(&bar[XB_XCNT(b.x)], 1u);
    return b;
}
DI void xcd_barrier_complete(unsigned* bar, unsigned x, unsigned& nloc, unsigned& nx) {
    const unsigned G = gridDim.x * gridDim.y * gridDim.z;
    unsigned sum, cnt, mine, sp = 0u;
    for (;;) {
        sum = 0u; cnt = 0u; mine = 0u;
#pragma unroll
        for (unsigned j = 0; j < 16; ++j) { const unsigned c = xb_ld(&bar[XB_XCNT(j)]); sum += c; cnt += (c > 0u) ? 1u : 0u; mine = (j == x) ? c : mine; }
        if (sum == G) break;
        __builtin_amdgcn_s_sleep(1);
        if ((++sp & 255u) == 0u) { if (xb_ld(&bar[XB_TMO])) break; if (sp > XB_SPIN_CAP) { atomicAdd(&bar[XB_TMO], 1u); break; } }
    }
    nloc = mine > 0u ? mine : 1u; nx = cnt > 0u ? cnt : 1u;
}
DI void xcd_barrier(const XcdBarrier& b) {
    asm volatile("s_waitcnt vmcnt(0)" ::: "memory");
    __syncthreads();
    if (threadIdx.x == 0) {
        unsigned* bar = b.bar;
        __builtin_amdgcn_s_waitcnt(0);
        unsigned nloc = b.st[0], nx = b.st[1];
        if (nloc == 0u) { xcd_barrier_complete(bar, b.x, nloc, nx); b.st[0] = nloc; b.st[1] = nx; }
        const unsigned old = xb_add(&bar[XB_XSUB(b.x)], 1u);
        const unsigned gen = old / nloc;
        if (old + 1u == (gen + 1u) * nloc) {
            __builtin_amdgcn_fence(__ATOMIC_RELEASE, "agent");
            asm volatile("s_waitcnt vmcnt(0)" ::: "memory");
            const unsigned og = xb_add(&bar[XB_TOP], 1u);
            const unsigned tg = og / nx;
            if (og + 1u == (tg + 1u) * nx) xb_add(&bar[XB_TOPGEN], 1u);
            else XB_SPIN(xb_ld(&bar[XB_TOPGEN]) == tg, bar);
            __builtin_amdgcn_fence(__ATOMIC_ACQUIRE, "agent");
            xb_add(&bar[XB_XGEN(b.x)], 1u);
            asm volatile("s_waitcnt vmcnt(0)" ::: "memory");
        } else {
            XB_SPIN(xb_ld(&bar[XB_XGEN(b.x)]) == gen, bar);
            __builtin_amdgcn_fence(__ATOMIC_ACQUIRE, "agent");
            asm volatile("s_waitcnt vmcnt(0)" ::: "memory");
        }
    }
    __syncthreads();
}

struct Args {
    const float* in[27];
    float* out; unsigned char* ws;
};
typedef const __attribute__((address_space(4))) Args* KArgs;

DI int win_src_col(int np) {
    if (np < 1536) return np;
    if (np < 3072) return np + 688;
    if (np < 3744) return np - 3072 + 1552;
    if (np < 3760) return np - 3744 + 1536;
    if (np < 3840) return -1;
    return np - 80;
}
struct WJob { const float* src; bf16_t* dst; const float* rs; int K, N, kt, nt, mode; };
DI void wconv_load(const WJob& j, float (&v)[8]) {
    int tid = threadIdx.x; asm volatile("" : "+v"(tid));
    const int nl = tid & 63, ks = tid >> 6;
    const int np = j.nt * 64 + nl;
    const int sc = (j.mode == 1) ? win_src_col(np) : np;
#pragma unroll
    for (int kk = 0; kk < 8; ++kk) { const int k = j.kt * 64 + ks * 8 + kk; float x = 0.f;
        if (j.mode == 2) { v[kk] = 0.f; continue; }
        if (sc >= 0) x = j.src[(size_t)k * j.N + sc];
        if (j.rs) x *= j.rs[k];
        v[kk] = x; }
}
DI void wconv_store(char* lds, const WJob& j, const float (&v)[8]) {
    float* tile = (float*)lds;
    int tid = threadIdx.x; asm volatile("" : "+v"(tid));
    const int nl = tid & 63, ks = tid >> 6;
    __syncthreads();
#pragma unroll
    for (int kk = 0; kk < 8; ++kk) tile[(ks * 8 + kk) * 65 + nl] = v[kk];
    __syncthreads();
    const int n2 = tid >> 3, kseg = tid & 7;
    float o[8];
#pragma unroll
    for (int q = 0; q < 8; ++q) o[q] = tile[(kseg * 8 + q) * 65 + n2];
    u32x4 w; w.x = pk2(o[0], o[1]); w.y = pk2(o[2], o[3]); w.z = pk2(o[4], o[5]); w.w = pk2(o[6], o[7]);
    *(u32x4*)(j.dst + (size_t)(j.nt * 64 + n2) * j.K + j.kt * 64 + kseg * 8) = w;
}
constexpr int WT_IN = 108 * 16, WT_MLWO = 16 * 8, WT_UQ = 12 * 6, WT_UKV = 16 * 6, WT_MLAWO = 16 * 8, WT_NAWO = 16 * 8, WT_WOUT = 16 * 16, WT_FF1 = 64 * 16, WT_FF2 = 16 * 64;
constexpr int WT_LAYER = WT_IN + WT_MLWO + WT_UQ + WT_UKV + WT_MLAWO + WT_NAWO + WT_WOUT + WT_FF1 + WT_FF2;
DI WJob wconv_decode(KArgs a, int item) {
    const int l = item / WT_LAYER; int r = item % WT_LAYER;
    unsigned char* wb = a->ws + WS_W + (size_t)l * W_LAYER;
    WJob j; j.mode = 0; j.rs = nullptr; int NT;
    if (r < WT_IN) { j.src = a->in[8] + (size_t)l * D * D_IN; j.dst = (bf16_t*)(wb + WO_IN); j.K = D; j.N = D_IN; NT = 108; j.mode = 1; }
    else if ((r -= WT_IN) < WT_MLWO) { j.src = a->in[12] + (size_t)l * 512 * D; j.dst = (bf16_t*)(wb + WO_MLWO); j.K = 512; j.N = D; NT = 16; }
    else if ((r -= WT_MLWO) < WT_UQ) { j.src = a->in[14] + (size_t)l * 384 * 768; j.dst = (bf16_t*)(wb + WO_UQ); j.K = 384; j.N = 768; NT = 12; j.rs = a->in[13] + l * 384; }
    else if ((r -= WT_UQ) < WT_UKV) { j.src = a->in[16] + (size_t)l * 256 * 1024; j.dst = (bf16_t*)(wb + WO_UKV); j.K = 384; j.N = 1024; NT = 16; j.rs = a->in[15] + l * 256; if (r >= 16 * 4) j.mode = 2; }
    else if ((r -= WT_UKV) < WT_MLAWO) { j.src = a->in[19] + (size_t)l * 512 * D; j.dst = (bf16_t*)(wb + WO_MLAWO); j.K = 512; j.N = D; NT = 16; }
    else if ((r -= WT_MLAWO) < WT_NAWO) { j.src = a->in[23] + (size_t)l * 512 * D; j.dst = (bf16_t*)(wb + WO_NAWO); j.K = 512; j.N = D; NT = 16; }
    else if ((r -= WT_NAWO) < WT_WOUT) { j.src = a->in[24] + (size_t)l * D * D; j.dst = (bf16_t*)(wb + WO_WOUT); j.K = D; j.N = D; NT = 16; }
    else if ((r -= WT_WOUT) < WT_FF1) { j.src = a->in[25] + (size_t)l * D * DFF; j.dst = (bf16_t*)(wb + WO_FF1); j.K = D; j.N = DFF; NT = 64; }
    else { r -= WT_FF1; j.src = a->in[26] + (size_t)l * DFF * D; j.dst = (bf16_t*)(wb + WO_FF2); j.K = DFF; j.N = D; NT = 16; }
    j.nt = r % NT; j.kt = r / NT;
    return j;
}
DI void wconv_range(char* lds, KArgs a, int first, int last, int stride) {
    int it = first; float v[8];
    if (it < last) { const WJob j = wconv_decode(a, it); wconv_load(j, v); }
    while (it < last) {
        const WJob j = wconv_decode(a, it);
        const int nx = it + stride; float v2[8];
#pragma unroll
        for (int q = 0; q < 8; ++q) v2[q] = 0.f;
        if (nx < last) { const WJob jn = wconv_decode(a, nx); wconv_load(jn, v2); }
        wconv_store(lds, j, v);
#pragma unroll
        for (int q = 0; q < 8; ++q) v[q] = v2[q];
        it = nx;
    }
    __syncthreads();
}
DI void mod_item(char* lds, KArgs a, int item) {
    float* sv = (float*)lds;
    float* red = sv + 9 * 1024;
    const int tid = threadIdx.x, l = item / 96, n0 = (item % 96) * 64;
    for (int i = tid; i < 9 * 1024; i += 512) { const float c = (i < 8 * 1024) ? a->in[1][i] : a->in[3][i - 8 * 1024]; sv[i] = c / (1.f + __expf(-c)); }
    __syncthreads();
    const int kg = tid >> 6, c = tid & 63;
    const float* w = a->in[4] + (size_t)l * D * 6 * D + n0 + c;
    float acc[9];
#pragma unroll
    for (int r = 0; r < 9; ++r) acc[r] = 0.f;
    for (int k0 = kg; k0 < D; k0 += 64) { float wv[8];
#pragma unroll
        for (int q = 0; q < 8; ++q) wv[q] = w[(size_t)(k0 + 8 * q) * 6 * D];
#pragma unroll
        for (int q = 0; q < 8; ++q)
#pragma unroll
            for (int r = 0; r < 9; ++r) acc[r] += sv[r * 1024 + k0 + 8 * q] * wv[q]; }
#pragma unroll
    for (int r = 0; r < 9; ++r) red[(kg * 9 + r) * 64 + c] = acc[r];
    __syncthreads();
    float* mod = (float*)(a->ws + WS_MOD) + (size_t)l * 9 * 6 * D;
    for (int i = tid; i < 9 * 64; i += 512) { const int r = i >> 6, cc = i & 63; float s = a->in[5][(size_t)l * 6 * D + n0 + cc];
#pragma unroll
        for (int q = 0; q < 8; ++q) s += red[(q * 9 + r) * 64 + cc];
        mod[(size_t)r * 6 * D + n0 + cc] = s; }
    __syncthreads();
}

DI void unpack8(const u32x4& w, float* o) { o[0] = bflo(w.x); o[1] = bfhi(w.x); o[2] = bflo(w.y); o[3] = bfhi(w.y); o[4] = bflo(w.z); o[5] = bfhi(w.z); o[6] = bflo(w.w); o[7] = bfhi(w.w); }
DI u32x4 packv8(const float* o) { u32x4 w; w.x = pk2(o[0], o[1]); w.y = pk2(o[2], o[3]); w.z = pk2(o[4], o[5]); w.w = pk2(o[6], o[7]); return w; }
DI void norm_phase(const float* src_lat, const float* src_ctx, int nlat, int ntot, int latoff, int ctxoff,
                   const float* __restrict__ gnorm, const float* __restrict__ modl, int shoff, int scoff, bf16_t* dst) {
    int tx_ = threadIdx.x; asm volatile("" : "+v"(tx_));
    const int lane = tx_ & 63, gw = blockIdx.x * 8 + (tx_ >> 6), nw = gridDim.x * 8;
    for (int r = gw; r < ntot; r += nw) {
        const bool lat = r < nlat;
        const float* x = lat ? src_lat + (size_t)(latoff + r) * D : src_ctx + (size_t)(ctxoff + r - nlat) * D;
        const int b = lat ? (latoff + r) / SEQ : NBATCH;
        const float* mb = modl + (size_t)b * 6 * D;
        f32x4 v[4], g[4], sc[4], sh[4]; float ss = 0.f;
#pragma unroll
        for (int i = 0; i < 4; ++i) { const int c = lane * 4 + 256 * i; v[i] = *(const f32x4*)(x + c); g[i] = *(const f32x4*)(gnorm + c); sc[i] = *(const f32x4*)(mb + scoff + c); sh[i] = *(const f32x4*)(mb + shoff + c); }
#pragma unroll
        for (int i = 0; i < 4; ++i) ss += v[i][0] * v[i][0] + v[i][1] * v[i][1] + v[i][2] * v[i][2] + v[i][3] * v[i][3];
        ss = wave_sum(ss);
        const float rstd = rsqrtf(ss * (1.f / D) + EPS);
#pragma unroll
        for (int i = 0; i < 4; ++i) { const int c = lane * 4 + 256 * i;
            f32x4 y;
#pragma unroll
            for (int j = 0; j < 4; ++j) y[j] = (v[i][j] * rstd * g[i][j]) * (1.f + sc[i][j]) + sh[i][j];
            u32x2 w; w.x = pk2(y[0], y[1]); w.y = pk2(y[2], y[3]);
            *(u32x2*)(dst + (size_t)r * D + c) = w; }
    }
}

DI void prep_phase(KArgs a, int l, bool want_ctx, bf16_t* P, const bf16_t* T, bf16_t* Qb, bf16_t* Qc, bf16_t* Kb, bf16_t* Vb, const float* ropetab) {
    int tx_ = threadIdx.x; asm volatile("" : "+v"(tx_));
    const int lane = tx_ & 63, gw = blockIdx.x * 8 + (tx_ >> 6), nw = gridDim.x * 8;
    const int hd = lane >> 3, k = lane & 7;
    const float* gq = a->in[17] + l * 96; const float* gk = a->in[18] + l * 96;
    float gqn[8], gqr[4], gkn[8], gkr[4], nqw[16];
#pragma unroll
    for (int i = 0; i < 8; ++i) { gqn[i] = gq[8 * k + i]; gkn[i] = gk[8 * k + i]; }
#pragma unroll
    for (int i = 0; i < 4; ++i) { gqr[i] = gq[64 + 4 * k + i]; gkr[i] = gk[64 + 4 * k + i]; }
    const float QS = 0.10206207261596577f * LOG2E, NAS = 0.125f * LOG2E;
    { const float* nw_ = (lane < 32) ? a->in[20] + l * 64 : a->in[21] + l * 64; const float sc_ = (lane < 32) ? NAS : 1.f;
#pragma unroll
      for (int i = 0; i < 16; ++i) nqw[i] = nw_[16 * (lane & 3) + i] * sc_; }
    const int sec = k >> 2, second = (k >> 1) & 1;
    for (int r = gw; r < MG; r += nw) {
        const bool lat = r < MG_LAT;
        int bl, tt, tall;
        if (lat) { bl = r / SEQ; tt = r % SEQ; tall = CTXL + tt; } else { const int rc = r - MG_LAT; bl = rc / CTXL; tt = rc % CTXL; tall = tt; }
        const bool need_q = lat || want_ctx;
        bf16_t* Pr = P + (size_t)r * NP; const bf16_t* Tr = T + (size_t)r * TW;
        const u32x4 d0 = *(const u32x4*)(Pr + PC_DQ + 8 * lane);
        u32x4 d1 = (u32x4){0u, 0u, 0u, 0u}; if (lane < 16) d1 = *(const u32x4*)(Pr + PC_DQ + 512 + 8 * lane);
        const u32x2 krw = *(const u32x2*)(Pr + PC_KR + 4 * k);
        const u32x4 tqn = *(const u32x4*)(Tr + hd * 96 + 8 * k); const u32x2 tqr = *(const u32x2*)(Tr + hd * 96 + 64 + 4 * k);
        const u32x4 tkn = *(const u32x4*)(Tr + 768 + hd * 128 + 8 * k), tv = *(const u32x4*)(Tr + 768 + hd * 128 + 64 + 8 * k);
        u32x4 na0 = *(const u32x4*)(Pr + PC_NAQ + 16 * lane), na1 = *(const u32x4*)(Pr + PC_NAQ + 16 * lane + 8);
        f32x4 rt0 = (f32x4){1.f, 0.f, 1.f, 0.f}, rt1 = rt0;
        if (lat) { const int pos = sec ? (tt & 63) : (tt >> 6); const float* rp = ropetab + (size_t)(pos * 8 + 4 * (k & 1)) * 2; rt0 = *(const f32x4*)rp; rt1 = *(const f32x4*)(rp + 4); }
        float e0[8], e1[8]; unpack8(d0, e0); unpack8(d1, e1);
        float s0 = 0.f, s1 = 0.f;
#pragma unroll
        for (int i = 0; i < 8; ++i) { s0 += e0[i] * e0[i]; s1 += e1[i] * e1[i]; }
        const float ssq = wave_sum(lane < 48 ? s0 : 0.f), skv = wave_sum((lane < 48 ? 0.f : s0) + s1);
        const float rstd_q = rsqrtf(ssq * (1.f / 384.f) + EPS), rstd_kv = rsqrtf(skv * (1.f / 256.f) + EPS);
        const float cs4[4] = {rt0[0], rt0[2], rt1[0], rt1[2]}, sn4[4] = {rt0[1], rt0[3], rt1[1], rt1[3]};
        if (need_q) {
            float xn[8], xr[4]; unpack8(tqn, xn); xr[0] = bflo(tqr.x); xr[1] = bfhi(tqr.x); xr[2] = bflo(tqr.y); xr[3] = bfhi(tqr.y);
            float ss = 0.f;
#pragma unroll
            for (int i = 0; i < 8; ++i) { xn[i] *= rstd_q; ss += xn[i] * xn[i]; }
#pragma unroll
            for (int i = 0; i < 4; ++i) { xr[i] *= rstd_q; ss += xr[i] * xr[i]; }
            const float rs = rsqrtf(sum8(ss) * (1.f / 96.f) + EPS) ;
#pragma unroll
            for (int i = 0; i < 8; ++i) xn[i] = xn[i] * rs * gqn[i] * QS;
#pragma unroll
            for (int i = 0; i < 4; ++i) { const float y = xr[i] * rs * gqr[i]; const float xp = dpp_f<0x4E>(y); xr[i] = (second ? y * cs4[i] + xp * sn4[i] : y * cs4[i] - xp * sn4[i]) * QS; }
            bf16_t* dst = lat ? Qb + ((size_t)(bl * 8 + hd) * SEQ + tt) * 96 : Qc + ((size_t)(bl * 8 + hd) * CTXL + tt) * 96;
            *(u32x4*)(dst + 8 * k) = packv8(xn); u32x2 w; w.x = pk2(xr[0], xr[1]); w.y = pk2(xr[2], xr[3]); *(u32x2*)(dst + 64 + 4 * k) = w;
        }
        {
            float xn[8], xr[4], vv[8]; unpack8(tkn, xn); unpack8(tv, vv); xr[0] = bflo(krw.x); xr[1] = bfhi(krw.x); xr[2] = bflo(krw.y); xr[3] = bfhi(krw.y);
            float ss = 0.f;
#pragma unroll
            for (int i = 0; i < 8; ++i) { xn[i] *= rstd_kv; vv[i] *= rstd_kv; ss += xn[i] * xn[i]; }
#pragma unroll
            for (int i = 0; i < 4; ++i) ss += xr[i] * xr[i];
            const float rs = rsqrtf(sum8(ss) * (1.f / 96.f) + EPS);
#pragma unroll
            for (int i = 0; i < 8; ++i) xn[i] = xn[i] * rs * gkn[i];
#pragma unroll
            for (int i = 0; i < 4; ++i) { const float y = xr[i] * rs * gkr[i]; const float xp = dpp_f<0x4E>(y); xr[i] = second ? y * cs4[i] + xp * sn4[i] : y * cs4[i] - xp * sn4[i]; }
            bf16_t* dst = Kb + ((size_t)(bl * 8 + hd) * TALL + tall) * 96;
            *(u32x4*)(dst + 8 * k) = packv8(xn); u32x2 w; w.x = pk2(xr[0], xr[1]); w.y = pk2(xr[2], xr[3]); *(u32x2*)(dst + 64 + 4 * k) = w;
            *(u32x4*)(Vb + ((size_t)(bl * 8 + hd) * TALL + tall) * 64 + 8 * k) = packv8(vv);
        }
        {
            float x0[8], x1[8]; unpack8(na0, x0); unpack8(na1, x1);
            float ss = 0.f;
#pragma unroll
            for (int i = 0; i < 8; ++i) ss += x0[i] * x0[i] + x1[i] * x1[i];
            const float rs = rsqrtf(sum4(ss) * (1.f / 64.f) + EPS);
#pragma unroll
            for (int i = 0; i < 8; ++i) { x0[i] = x0[i] * rs * nqw[i]; x1[i] = x1[i] * rs * nqw[8 + i]; }
            *(u32x4*)(Pr + PC_NAQ + 16 * lane) = packv8(x0); *(u32x4*)(Pr + PC_NAQ + 16 * lane + 8) = packv8(x1);
        }
    }
}

DI void mlcomb_phase(KArgs a, int l, int nrows, bf16_t* P, const bf16_t* HD0, const bf16_t* HD1) {
    int tx_ = threadIdx.x; asm volatile("" : "+v"(tx_));
    const int lane = tx_ & 63, gw = blockIdx.x * 8 + (tx_ >> 6), nw = gridDim.x * 8;
    const float* gout = a->in[11] + l * 512 + 8 * lane;
    float go[8];
#pragma unroll
    for (int i = 0; i < 8; ++i) go[i] = gout[i];
    for (int r = gw; r < nrows; r += nw) {
        bf16_t* Pr = P + (size_t)r * NP + PC_MLO + 8 * lane;
        const u32x4 w0 = *(const u32x4*)(HD0 + (size_t)r * 512 + 8 * lane), w1 = *(const u32x4*)(HD1 + (size_t)r * 512 + 8 * lane), wo = *(const u32x4*)Pr;
        float h0[8], h1[8], o[8]; unpack8(w0, h0); unpack8(w1, h1); unpack8(wo, o);
        float ss = 0.f;
#pragma unroll
        for (int i = 0; i < 8; ++i) { h0[i] += h1[i]; ss += h0[i] * h0[i]; }
        const float rs = rsqrtf(sum16(ss) * (1.f / 128.f) + EPS);
#pragma unroll
        for (int i = 0; i < 8; ++i) h0[i] = h0[i] * rs * go[i] * sigmoidf_(o[i]);
        *(u32x4*)Pr = packv8(h0);
    }
}

DI float max3f(float a, float b, float c) { float r; asm("v_max3_f32 %0, %1, %2, %3" : "=v"(r) : "v"(a), "v"(b), "v"(c)); return r; }
DI float max2f(float a, float b) { float r; asm("v_max_f32_e32 %0, %1, %2" : "=v"(r) : "v"(a), "v"(b)); return r; }
typedef short s16x4 __attribute__((ext_vector_type(4)));
DI s16x4 vtr(const LAS char* p) { return __builtin_bit_cast(s16x4, __builtin_amdgcn_ds_read_tr16_b64_v4i16((LAS s16x4*)p)); }
DI int crow(int reg, int h) { return (reg & 3) + 8 * (reg >> 2) + 4 * h; }
#define MFMA32(a, b, c) __builtin_amdgcn_mfma_f32_32x32x16_bf16((a), (b), (c), 0, 0, 0)
DI bf16x8 pack8(const f32x16& x, int s) {
    u32x4 p; p.x = pk2(x[8 * s], x[8 * s + 1]); p.y = pk2(x[8 * s + 2], x[8 * s + 3]); p.z = pk2(x[8 * s + 4], x[8 * s + 5]); p.w = pk2(x[8 * s + 6], x[8 * s + 7]);
    return __builtin_bit_cast(bf16x8, p);
}
struct AttnP {
    const bf16_t* Q; int q_ld;
    const bf16_t* Kb; const bf16_t* Vb;
    const bf16_t* Kc; const bf16_t* Vc;
    bf16_t* O; int o_ld;
    int ntiles, nb, rlo, r0;
    const float* rpb;
    int fix;
    float C;
};
template <int MODE, bool FIX>
DI void attn_unit(char* lds, const AttnP& p) {
    constexpr int DQK = MODE == 0 ? 96 : 64, NST = DQK / 16, NCH = DQK / 8, KSTRB = (DQK + 8) * 2, VSTRB = 144, KBUF = 13312, VBUF = 9216;
    char* Kb0 = lds; char* Vb0 = lds + 2 * KBUF; float* rpbL = (float*)(lds + 2 * KBUF + 2 * VBUF);
    int tid = threadIdx.x; asm volatile("" : "+v"(tid));
    const int w = tid >> 6, lane = tid & 63, r = lane & 31, h = lane >> 5;
    const int nt = p.ntiles;
    bf16x8 qf[NST];
    { const bf16_t* qp = p.Q + (size_t)(32 * w + r) * p.q_ld + 8 * h;
#pragma unroll
      for (int st = 0; st < NST; ++st) qf[st] = *(const bf16x8*)(qp + 16 * st); }
    f32x16 o0, o1, p0, p1, n0, n1;
#pragma unroll
    for (int i = 0; i < 16; ++i) { o0[i] = 0.f; o1[i] = 0.f; p0[i] = 0.f; p1[i] = 0.f; n0[i] = 0.f; n1[i] = 0.f; }
    float m_run = -1e30f, l_run = 0.f;
    const float sinit = FIX ? -p.C : 0.f;
    const int rq = p.r0 + (w >> 1), rs = min(max(rq - 4, 0), 56), qc = 32 * (w & 1) + r, cs = min(max(qc - 8, 0), 48);
    unsigned idxp0[4], idxp1[4];
    if (MODE == 1) {
        for (int i = tid; i < 480; i += 512) { const int dr = i >> 5, d = i & 31; rpbL[i] = (d < 31) ? p.rpb[dr * 31 + d] * LOG2E : -1e30f; }
#pragma unroll
        for (int k4 = 0; k4 < 4; ++k4) { unsigned a0 = 0u, a1 = 0u;
#pragma unroll
            for (int m = 0; m < 4; ++m) { const int i = 4 * k4 + m; const int c0 = crow(i, h), c1 = 32 + c0;
                a0 |= (unsigned)((((unsigned)(c0 - cs) < 16u) ? (c0 - qc + 15) : 31) * 4) << (8 * m);
                a1 |= (unsigned)((((unsigned)(c1 - cs) < 16u) ? (c1 - qc + 15) : 31) * 4) << (8 * m); }
            idxp0[k4] = a0; idxp1[k4] = a1; }
    }
    const int krow0 = tid / NCH, kch0 = tid % NCH, krow1 = (tid + 512) / NCH, kch1 = (tid + 512) % NCH;
    const bool k2 = (MODE == 0) && (tid < 256);
    const int vkey = tid >> 3, vdg = tid & 7;
    u32x4 kr0, kr1 = (u32x4){0u, 0u, 0u, 0u}, vr, kx0 = (u32x4){0u, 0u, 0u, 0u}, kx1 = (u32x4){0u, 0u, 0u, 0u}, vx = (u32x4){0u, 0u, 0u, 0u};
#define ATT_KV(j) const bf16_t* kp; const bf16_t* vp; size_t kld, vld; \
        if (MODE == 0) { kp = p.Kb + (size_t)(j) * 64 * 96; vp = p.Vb + (size_t)(j) * 64 * 64; kld = 96; vld = 64; } \
        else if ((j) < p.nb) { kp = p.Kb + (size_t)(p.rlo + (j)) * 64 * NP; vp = p.Vb + (size_t)(p.rlo + (j)) * 64 * NP; kld = NP; vld = NP; } \
        else { kp = p.Kc + (size_t)((j) - p.nb) * 64 * NP; vp = p.Vc + (size_t)((j) - p.nb) * 64 * NP; kld = NP; vld = NP; }
#define ATT_LOADK(j) do { ATT_KV(j); (void)vp; (void)vld; kr0 = *(const u32x4*)(kp + (size_t)krow0 * kld + kch0 * 8); if (k2) kr1 = *(const u32x4*)(kp + (size_t)krow1 * kld + kch1 * 8); } while (0)
#define ATT_LOADV(j) do { ATT_KV(j); (void)kp; (void)kld; vr = *(const u32x4*)(vp + (size_t)vkey * vld + vdg * 8); } while (0)
#define ATT_LOADKX(j) do { ATT_KV(j); (void)vp; (void)vld; kx0 = *(const u32x4*)(kp + (size_t)krow0 * kld + kch0 * 8); if (k2) kx1 = *(const u32x4*)(kp + (size_t)krow1 * kld + kch1 * 8); } while (0)
#define ATT_LOADVX(j) do { ATT_KV(j); (void)kp; (void)kld; vx = *(const u32x4*)(vp + (size_t)vkey * vld + vdg * 8); } while (0)
#define ATT_STOREK(b) do { char* Ks_ = Kb0 + (b) * KBUF; *(u32x4*)(Ks_ + krow0 * KSTRB + kch0 * 16) = kr0; if (k2) *(u32x4*)(Ks_ + krow1 * KSTRB + kch1 * 16) = kr1; } while (0)
#define ATT_STOREV(b) do { *(u32x4*)(Vb0 + (b) * VBUF + vkey * VSTRB + vdg * 16) = vr; } while (0)
#define ATT_QK(S0, S1, b) do { const char* Ks_ = Kb0 + (b) * KBUF + r * KSTRB + 16 * h; \
        _Pragma("unroll") for (int i_ = 0; i_ < 16; ++i_) { S0[i_] = sinit; S1[i_] = sinit; } \
        _Pragma("unroll") for (int st = 0; st < NST; ++st) { const bf16x8 a0 = *(const bf16x8*)(Ks_ + 32 * st), a1 = *(const bf16x8*)(Ks_ + 32 * KSTRB + 32 * st); \
            S0 = MFMA32(a0, qf[st], S0); S1 = MFMA32(a1, qf[st], S1); } } while (0)
#define ATT_ACT(j) (!((MODE == 1) && ((j) < p.nb) && !((p.rlo + (j)) >= rs && (p.rlo + (j)) < rs + 8)))
    ATT_LOADK(0); ATT_LOADV(0); ATT_STOREK(0); ATT_STOREV(0);
    if (nt > 1) { ATT_LOADK(1); ATT_STOREK(1); }
    if (nt > 2) ATT_LOADK(2);
    if (nt > 1) ATT_LOADV(1);
    __syncthreads();
    if (ATT_ACT(0)) ATT_QK(p0, p1, 0);
    __syncthreads();
    int j = 0;
#pragma unroll
    for (int ph = 0; ph < 2; ++ph) {
    const bool FULL = (ph == 0);
    const int jend = FULL ? nt - 3 : nt;
    for (; j < jend; ++j) {
        if (FULL || j + 2 < nt) ATT_STOREK(j & 1);
        if (FULL || j + 1 < nt) ATT_STOREV((j + 1) & 1);
        if (FULL || j + 3 < nt) ATT_LOADK(j + 3);
        if (FULL || j + 2 < nt) ATT_LOADV(j + 2);
        if (MODE == 0) { ATT_QK(n0, n1, (j + 1) & 1); }
        else if (j + 1 < nt && ATT_ACT(j + 1)) { ATT_QK(n0, n1, (j + 1) & 1); }
        if (ATT_ACT(j)) {
            if ((MODE == 1) && (j < p.nb)) {
                const char* browb = (const char*)(rpbL + (p.rlo + j - rq + 7) * 32);
#pragma unroll
                for (int i = 0; i < 16; ++i) { p0[i] += *(const float*)(browb + ((idxp0[i >> 2] >> (8 * (i & 3))) & 0xffu)); p1[i] += *(const float*)(browb + ((idxp1[i >> 2] >> (8 * (i & 3))) & 0xffu)); }
            }
            if (FIX) {
#pragma unroll
                for (int i = 0; i < 16; ++i) { p0[i] = __builtin_amdgcn_exp2f(p0[i]); p1[i] = __builtin_amdgcn_exp2f(p1[i]); }
                const f32x16 ps = p0 + p1;
                l_run += ((ps[0] + ps[1]) + (ps[2] + ps[3])) + ((ps[4] + ps[5]) + (ps[6] + ps[7])) + ((ps[8] + ps[9]) + (ps[10] + ps[11])) + ((ps[12] + ps[13]) + (ps[14] + ps[15]));
            } else {
            float tmax = max2f(p0[0], p1[0]), tmax2 = max2f(p0[1], p1[1]);
#pragma unroll
            for (int i = 2; i < 16; i += 2) { tmax = max3f(tmax, p0[i], p1[i]); tmax2 = max3f(tmax2, p0[i + 1], p1[i + 1]); }
            tmax = max2f(tmax, tmax2);
            tmax = max2f(tmax, shx(tmax, lane, 32));
            const float m_new = max2f(m_run, tmax), alpha = __builtin_amdgcn_exp2f(m_run - m_new);
            p0 = p0 - m_new; p1 = p1 - m_new;
#pragma unroll
            for (int i = 0; i < 16; ++i) { p0[i] = __builtin_amdgcn_exp2f(p0[i]); p1[i] = __builtin_amdgcn_exp2f(p1[i]); }
            const f32x16 ps = p0 + p1;
            float rsum = ((ps[0] + ps[1]) + (ps[2] + ps[3])) + ((ps[4] + ps[5]) + (ps[6] + ps[7])) + ((ps[8] + ps[9]) + (ps[10] + ps[11])) + ((ps[12] + ps[13]) + (ps[14] + ps[15]));
            rsum += shx(rsum, lane, 32);
            l_run = l_run * alpha + rsum; m_run = m_new;
            o0 = o0 * alpha; o1 = o1 * alpha;
            }
            const LAS char* vbase = (const LAS char*)(Vb0 + (j & 1) * VBUF) + (4 * h + ((lane & 15) >> 2)) * VSTRB + ((lane >> 4) & 1) * 32 + (lane & 3) * 8;
#pragma unroll
            for (int kb = 0; kb < 2; ++kb)
#pragma unroll
                for (int s = 0; s < 2; ++s) {
                    const bf16x8 pf = pack8(kb ? p1 : p0, s);
                    const LAS char* vb = vbase + (32 * kb + 16 * s) * VSTRB;
                    const s16x4 l0 = vtr(vb), h0 = vtr(vb + 8 * VSTRB), l1 = vtr(vb + 64), h1 = vtr(vb + 8 * VSTRB + 64);
                    const bf16x8 v0 = __builtin_shufflevector(l0, h0, 0, 1, 2, 3, 4, 5, 6, 7), v1 = __builtin_shufflevector(l1, h1, 0, 1, 2, 3, 4, 5, 6, 7);
                    o0 = MFMA32(v0, pf, o0); o1 = MFMA32(v1, pf, o1);
                }
        }
        __syncthreads();
        p0 = n0; p1 = n1;
    }
    }
#undef ATT_KV
#undef ATT_LOADK
#undef ATT_LOADV
#undef ATT_LOADKX
#undef ATT_LOADVX
#undef ATT_STOREK
#undef ATT_STOREV
#undef ATT_QK
#undef ATT_ACT
    if (FIX) l_run += shx(l_run, lane, 32);
    const float inv = 1.f / l_run;
    bf16_t* op = p.O + (size_t)(32 * w + r) * p.o_ld + 4 * h;
#pragma unroll
    for (int i4 = 0; i4 < 4; ++i4) {
        u32x2 w0, w1; w0.x = pk2(o0[4 * i4] * inv, o0[4 * i4 + 1] * inv); w0.y = pk2(o0[4 * i4 + 2] * inv, o0[4 * i4 + 3] * inv);
        w1.x = pk2(o1[4 * i4] * inv, o1[4 * i4 + 1] * inv); w1.y = pk2(o1[4 * i4 + 2] * inv, o1[4 * i4 + 3] * inv);
        *(u32x2*)(op + 8 * i4) = w0; *(u32x2*)(op + 32 + 8 * i4) = w1;
    }
}

#define ML_ROW(ci, t) (((ci) < 4) ? (MG_LAT + bl * CTXL + (dir ? (3 - (ci)) * 64 + 63 - (t) : (ci) * 64 + (t))) : (bl * SEQ + (dir ? (67 - (ci)) * 64 + 63 - (t) : ((ci) - 4) * 64 + (t))))
constexpr int ML_NSEQ = 32, ML_NCH = 68, ML_ITEMS = ML_NSEQ * ML_NCH;
constexpr size_t WS_DC = WS_H, WS_CS = 475 * MiB, WS_SM = 509 * MiB, SM_DN = 0, SM_NST = 0x90000, SM_SCAL = 0x120000, SM_MST = 0x128000, SM_TAB = 0x130000;
DI void mlA_phase(char* lds, KArgs a, int l, const bf16_t* P, unsigned char* ws) {
    constexpr int STR = 144;
    char* KTs = lds + 18432; char* VTs = lds + 27648;
    float* tab = (float*)(lds + 64512); float* tu = tab; float* misc = tab + 384;
    int tid = threadIdx.x; asm volatile("" : "+v"(tid));
    const int w = tid >> 6, lane = tid & 63, r = lane & 31, h = lane >> 5, eb = w >> 1, xb = w & 1;
    const int srow = tid >> 3, sch = tid & 7;
    const int G = gridDim.x;
    u32x4 rk, rv0, rv1; float gi = 0.f, gf = 0.f;
#define MLA_LOAD(item) do { const int sq_ = (item) / ML_NCH, ci_ = (item) % ML_NCH, dir = sq_ & 1, hh_ = (sq_ >> 1) & 3, bl = sq_ >> 3; \
        const bf16_t* pr = P + (size_t)ML_ROW(ci_, srow) * NP; \
        rk = *(const u32x4*)(pr + PC_MLK + hh_ * 64 + sch * 8); rv0 = *(const u32x4*)(pr + PC_MLV + hh_ * 128 + sch * 8); rv1 = *(const u32x4*)(pr + PC_MLV + hh_ * 128 + 64 + sch * 8); \
        if (w == 0) { const bf16_t* pg = P + (size_t)ML_ROW(ci_, lane) * NP + PC_GT; gi = bf2f(pg[(2 * dir) * 4 + hh_]); gf = bf2f(pg[(2 * dir + 1) * 4 + hh_]); } } while (0)
    int item = blockIdx.x;
    if (item < ML_ITEMS) MLA_LOAD(item);
    for (; item < ML_ITEMS; item += G) {
        const int sq = item / ML_NCH, dir = sq & 1, hh = (sq >> 1) & 3;
        if (w == 0) {
            const float ib = a->in[9][(l * 2 + dir) * 4 + hh], fb = a->in[10][(l * 2 + dir) * 4 + hh];
            const float x = gf + fb;
            const float lf = fminf(x, 0.f) - log1pf(expf(-fabsf(x)));
            float bc = lf;
#pragma unroll
            for (int o = 1; o < 64; o <<= 1) { const float v = shu(bc, lane, o); if (lane >= o) bc += v; }
            const float u = gi + ib - bc;
            float am = u;
#pragma unroll
            for (int o = 1; o < 64; o <<= 1) { const float v = shu(am, lane, o); if (lane >= o) am = fmaxf(am, v); }
            { float* tb = (float*)(ws + WS_SM + SM_TAB) + (size_t)item * 192; tb[lane] = u; tb[64 + lane] = bc; tb[128 + lane] = am; }
            tu[lane] = u;
            const float btot = rdl63(bc); am = rdl63(am);
            if (lane == 0) { misc[1] = am; float* sc = (float*)(ws + WS_SM + SM_SCAL) + (size_t)item * 2; sc[0] = btot; sc[1] = am; }
        }
        { const unsigned vw[8] = {rv0.x, rv0.y, rv0.z, rv0.w, rv1.x, rv1.y, rv1.z, rv1.w};
#pragma unroll
          for (int i = 0; i < 8; ++i) { const int e = (i < 4 ? 0 : 64) + sch * 8 + 2 * (i & 3);
              *(bf16_t*)(VTs + e * STR + srow * 2) = (bf16_t)(vw[i] & 0xffffu); *(bf16_t*)(VTs + (e + 1) * STR + srow * 2) = (bf16_t)(vw[i] >> 16); } }
        __syncthreads();
        { const float wk = __expf(tu[srow] - misc[1]);
          const unsigned kw[4] = {rk.x, rk.y, rk.z, rk.w};
#pragma unroll
          for (int i = 0; i < 4; ++i) { *(bf16_t*)(KTs + (sch * 8 + 2 * i) * STR + srow * 2) = f2bf(bflo(kw[i]) * wk); *(bf16_t*)(KTs + (sch * 8 + 2 * i + 1) * STR + srow * 2) = f2bf(bfhi(kw[i]) * wk); } }
        if (item + G < ML_ITEMS) MLA_LOAD(item + G);
        __syncthreads();
        {
            f32x16 C;
#pragma unroll
            for (int i = 0; i < 16; ++i) C[i] = 0.f;
#pragma unroll
            for (int st = 0; st < 4; ++st) {
                const bf16x8 vA = *(const bf16x8*)(VTs + (32 * eb + r) * STR + (16 * st + 8 * h) * 2), kB = *(const bf16x8*)(KTs + (32 * xb + r) * STR + (16 * st + 8 * h) * 2);
                C = MFMA32(vA, kB, C);
            }
            bf16_t* dc = (bf16_t*)(ws + WS_DC) + (size_t)item * 8192;
#pragma unroll
            for (int i = 0; i < 16; ++i) dc[(32 * eb + crow(i, h)) * 64 + 32 * xb + r] = f2bf(C[i]);
            const u32x4 kk = *(const u32x4*)(KTs + srow * STR + sch * 16);
            float sm = bflo(kk.x) + bfhi(kk.x) + bflo(kk.y) + bfhi(kk.y) + bflo(kk.z) + bfhi(kk.z) + bflo(kk.w) + bfhi(kk.w);
            sm += shx(sm, lane, 1); sm += shx(sm, lane, 2); sm += shx(sm, lane, 4);
            if (sch == 0) ((float*)(ws + WS_SM + SM_DN))[(size_t)item * 64 + srow] = sm;
        }
        __syncthreads();
    }
#undef MLA_LOAD
}
DI void mlB_phase(char* lds, unsigned char* ws) {
    int tx_ = threadIdx.x; asm volatile("" : "+v"(tx_));
    const int gt = blockIdx.x * 512 + tx_;
    const int sq = (blockIdx.x * 512) >> 12, pi = gt & 4095;
    float* sA = (float*)lds; float* sB = sA + 80; float* sM = sA + 160; float* sBt = sA + 240; float* sMl = sA + 320;
    if (sq >= ML_NSEQ) return;
    if (tx_ < ML_NCH) { const float* sc = (const float*)(ws + WS_SM + SM_SCAL) + ((size_t)sq * ML_NCH + tx_) * 2; sBt[tx_] = sc[0]; sMl[tx_] = sc[1]; }
    __syncthreads();
    if (tx_ == 0) { float m = 0.f;
        for (int ci = 0; ci < ML_NCH; ++ci) { const float M = fmaxf(m, sMl[ci]); sA[ci] = __expf(m - M); sB[ci] = __expf(sMl[ci] - M); sM[ci] = m; m = sBt[ci] + M; } }
    __syncthreads();
    const unsigned* __restrict__ dc = (const unsigned*)(ws + WS_DC) + (size_t)sq * ML_NCH * 4096 + pi;
    unsigned* __restrict__ cs = (unsigned*)(ws + WS_CS) + (size_t)sq * ML_NCH * 4096 + pi;
    const float* __restrict__ dn = (const float*)(ws + WS_SM + SM_DN) + (size_t)sq * ML_NCH * 64 + pi;
    float* __restrict__ nst = (float*)(ws + WS_SM + SM_NST) + (size_t)sq * ML_NCH * 64 + pi;
    float* __restrict__ mst = (float*)(ws + WS_SM + SM_MST) + (size_t)sq * ML_NCH;
    float c0 = 0.f, c1 = 0.f, n = 0.f;
    for (int cb = 0; cb < ML_NCH; cb += 17) {
        unsigned dv[17]; float dnv[17];
#pragma unroll
        for (int q = 0; q < 17; ++q) { dv[q] = dc[(size_t)(cb + q) * 4096]; dnv[q] = (pi < 64) ? dn[(size_t)(cb + q) * 64] : 0.f; }
#pragma unroll
        for (int q = 0; q < 17; ++q) {
            const int ci = cb + q;
            cs[(size_t)ci * 4096] = pk2(c0, c1);
            if (pi < 64) nst[(size_t)ci * 64] = n;
            if (pi == 0) mst[ci] = sM[ci];
            const float aa = sA[ci], bb = sB[ci];
            c0 = aa * c0 + bb * bflo(dv[q]); c1 = aa * c1 + bb * bfhi(dv[q]); n = aa * n + bb * dnv[q];
        }
    }
    __syncthreads();
}
DI void mlC_phase(char* lds, const bf16_t* P, unsigned char* ws, bf16_t* HD0, bf16_t* HD1) {
    constexpr int STR = 144;
    char* Qs = lds; char* Ks = lds + 9216; char* VTs = lds + 27648; char* CTs = lds + 46080;
    float* tab = (float*)(lds + 64512); float* tu = tab; float* tM = tab + 64; float* tbc = tab + 128; float* tain = tab + 192; float* qn = tab + 320;
    int tid = threadIdx.x; asm volatile("" : "+v"(tid));
    const int w = tid >> 6, lane = tid & 63, r = lane & 31, h = lane >> 5, eb = w >> 1, xb = w & 1;
    const int srow = tid >> 3, sch = tid & 7, G = gridDim.x;
    u32x4 rq, rk, rv0, rv1, cs0, cs1; f32x4 n0, n1; float m_state = 0.f, gu = 0.f, gbc = 0.f, gam = 0.f;
#define MLC_LOAD(item) do { const int sq_ = (item) / ML_NCH, ci_ = (item) % ML_NCH, dir = sq_ & 1, hh_ = (sq_ >> 1) & 3, bl = sq_ >> 3; \
        const bf16_t* pr = P + (size_t)ML_ROW(ci_, srow) * NP; \
        rq = *(const u32x4*)(pr + PC_MLQ + hh_ * 64 + sch * 8); rk = *(const u32x4*)(pr + PC_MLK + hh_ * 64 + sch * 8); \
        rv0 = *(const u32x4*)(pr + PC_MLV + hh_ * 128 + sch * 8); rv1 = *(const u32x4*)(pr + PC_MLV + hh_ * 128 + 64 + sch * 8); \
        const u32x4* csp = (const u32x4*)((const bf16_t*)(ws + WS_CS) + (size_t)(item) * 8192); cs0 = csp[tid]; cs1 = csp[tid + 512]; \
        const float* nstp = (const float*)(ws + WS_SM + SM_NST) + (size_t)(item) * 64 + sch * 8; n0 = *(const f32x4*)nstp; n1 = *(const f32x4*)(nstp + 4); \
        m_state = ((const float*)(ws + WS_SM + SM_MST))[item]; \
        if (w == 0) { const float* tb = (const float*)(ws + WS_SM + SM_TAB) + (size_t)(item) * 192; gu = tb[lane]; gbc = tb[64 + lane]; gam = tb[128 + lane]; } } while (0)
    int item = blockIdx.x;
    if (item < ML_ITEMS) MLC_LOAD(item);
    for (; item < ML_ITEMS; item += G) {
        const int sq = item / ML_NCH, ci = item % ML_NCH, dir = sq & 1, hh = (sq >> 1) & 3, bl = sq >> 3;
        bf16_t* HD = dir ? HD1 : HD0;
        if (w == 0) { const float Mt = fmaxf(m_state, gam); tu[lane] = gu; tM[lane] = Mt; tbc[lane] = gbc; tain[lane] = __expf(m_state - Mt); }
        float qv[8];
        { const unsigned qw[4] = {rq.x, rq.y, rq.z, rq.w};
#pragma unroll
          for (int i = 0; i < 4; ++i) { qv[2 * i] = bflo(qw[i]) * 0.125f; qv[2 * i + 1] = bfhi(qw[i]) * 0.125f; } }
        { u32x4 qs; qs.x = pk2(qv[0], qv[1]); qs.y = pk2(qv[2], qv[3]); qs.z = pk2(qv[4], qv[5]); qs.w = pk2(qv[6], qv[7]);
          *(u32x4*)(Qs + srow * STR + sch * 16) = qs; *(u32x4*)(Ks + srow * STR + sch * 16) = rk; }
        { const unsigned vw[8] = {rv0.x, rv0.y, rv0.z, rv0.w, rv1.x, rv1.y, rv1.z, rv1.w};
#pragma unroll
          for (int i = 0; i < 8; ++i) { const int e = (i < 4 ? 0 : 64) + sch * 8 + 2 * (i & 3);
              *(bf16_t*)(VTs + e * STR + srow * 2) = (bf16_t)(vw[i] & 0xffffu); *(bf16_t*)(VTs + (e + 1) * STR + srow * 2) = (bf16_t)(vw[i] >> 16); } }
        *(u32x4*)(CTs + (tid >> 3) * STR + (tid & 7) * 16) = cs0; *(u32x4*)(CTs + (64 + (tid >> 3)) * STR + (tid & 7) * 16) = cs1;
        { float sm = qv[0] * n0[0] + qv[1] * n0[1] + qv[2] * n0[2] + qv[3] * n0[3] + qv[4] * n1[0] + qv[5] * n1[1] + qv[6] * n1[2] + qv[7] * n1[3];
          sm += shx(sm, lane, 1); sm += shx(sm, lane, 2); sm += shx(sm, lane, 4);
          if (sch == 0) qn[srow] = sm; }
        if (item + G < ML_ITEMS) MLC_LOAD(item + G);
        __syncthreads();
        {
            const int t = 32 * xb + r;
            f32x16 X0, X1, Y;
#pragma unroll
            for (int i = 0; i < 16; ++i) { X0[i] = 0.f; X1[i] = 0.f; Y[i] = 0.f; }
#pragma unroll
            for (int st = 0; st < 4; ++st) {
                const bf16x8 qB = *(const bf16x8*)(Qs + t * STR + (16 * st + 8 * h) * 2);
                const bf16x8 k0 = *(const bf16x8*)(Ks + r * STR + (16 * st + 8 * h) * 2), k1 = *(const bf16x8*)(Ks + (32 + r) * STR + (16 * st + 8 * h) * 2);
                const bf16x8 cA = *(const bf16x8*)(CTs + (32 * eb + r) * STR + (16 * st + 8 * h) * 2);
                X0 = MFMA32(k0, qB, X0); X1 = MFMA32(k1, qB, X1); Y = MFMA32(cA, qB, Y);
            }
            const float Mtt = tM[t], ai = tain[t];
            float dsum = 0.f;
#pragma unroll
            for (int i = 0; i < 16; ++i) {
                const int s0 = crow(i, h), s1 = 32 + s0;
                X0[i] = (s0 <= t) ? X0[i] * __expf(tu[s0] - Mtt) : 0.f;
                X1[i] = (s1 <= t) ? X1[i] * __expf(tu[s1] - Mtt) : 0.f;
                dsum += X0[i] + X1[i]; Y[i] *= ai;
            }
            dsum += shx(dsum, lane, 32);
#pragma unroll
            for (int sb = 0; sb < 2; ++sb)
#pragma unroll
                for (int s2 = 0; s2 < 2; ++s2) {
                    const bf16x8 pf = pack8(sb ? X1 : X0, s2);
                    const char* vb = VTs + (32 * eb + r) * STR + (32 * sb + 16 * s2 + 4 * h) * 2;
                    const u32x2 lo = *(const u32x2*)vb, hi = *(const u32x2*)(vb + 16);
                    Y = MFMA32(__builtin_bit_cast(bf16x8, (u32x4){lo.x, lo.y, hi.x, hi.y}), pf, Y);
                }
            const float den = ai * qn[t] + dsum;
            const float inv = 1.f / fmaxf(fabsf(den), __expf(-(tbc[t] + Mtt)));
            bf16_t* op = HD + (size_t)ML_ROW(ci, t) * 512 + hh * 128 + 32 * eb + 4 * h;
#pragma unroll
            for (int i4 = 0; i4 < 4; ++i4) { u32x2 wv; wv.x = pk2(Y[4 * i4] * inv, Y[4 * i4 + 1] * inv); wv.y = pk2(Y[4 * i4 + 2] * inv, Y[4 * i4 + 3] * inv); *(u32x2*)(op + 8 * i4) = wv; }
        }
        __syncthreads();
    }
#undef MLC_LOAD
}

DI int mx_take(volatile int* s_item, unsigned* ctr) {
    if (threadIdx.x == 0) *s_item = (int)atomicAdd(ctr, 1u);
    __syncthreads();
    const int it = *s_item;
    __syncthreads();
    return it;
}
DI void mixer_phase(char* lds, KArgs a, int l, bool want_ctx, unsigned* ctr, unsigned char* ws, bf16_t* P, const bf16_t* Qb, const bf16_t* Qc, const bf16_t* Kb, const bf16_t* Vb, bf16_t* HD0, bf16_t* HD1) {
    volatile int* s_item = (volatile int*)(lds + 140000);
    const int x = (int)(xb_xcc_id() & 7u);
    { float Cmla, Cna; bool fix; int tx_ = threadIdx.x; asm volatile("" : "+v"(tx_)); const int lane = tx_ & 63;
      float gq = 0.f, gk = 0.f, nq = 0.f, nk = 0.f, rb = 0.f;
      for (int i = lane; i < 96; i += 64) { gq = fmaxf(gq, fabsf(a->in[17][l * 96 + i])); gk = fmaxf(gk, fabsf(a->in[18][l * 96 + i])); }
      nq = fabsf(a->in[20][l * 64 + lane]); nk = fabsf(a->in[21][l * 64 + lane]);
      for (int i = lane; i < 8 * 465; i += 64) rb = fmaxf(rb, fabsf(a->in[22][(size_t)l * 8 * 465 + i]));
#pragma unroll
      for (int o = 32; o >= 1; o >>= 1) { gq = fmaxf(gq, shx(gq, lane, o)); gk = fmaxf(gk, shx(gk, lane, o)); nq = fmaxf(nq, shx(nq, lane, o)); nk = fmaxf(nk, shx(nk, lane, o)); rb = fmaxf(rb, shx(rb, lane, o)); }
      Cmla = 9.79796f * gq * gk * LOG2E * 1.02f + 0.05f;
      Cna = (8.f * nq * nk * 1.02f + rb) * LOG2E + 0.05f;
      fix = (Cmla < 40.f) && (Cna < 40.f) && (Cmla == Cmla) && (Cna == Cna);
      volatile float* sc_ = (volatile float*)(lds + 140048);
      if (threadIdx.x == 0) { sc_[0] = Cmla; sc_[1] = Cna; sc_[2] = fix ? 1.f : 0.f; }
      __syncthreads(); }
#define MX_CMLA (((volatile float*)(lds + 140048))[0])
#define MX_CNA (((volatile float*)(lds + 140048))[1])
#define MX_FIX ((((volatile float*)(lds + 140048))[2]) != 0.f)
    const int nq = want_ctx ? 136 : 128;
    for (int k = 0; k < 8; ++k) {
        const int q = (x + k) & 7;
        for (;;) {
            const int i = mx_take(s_item, ctr + 1 + q);
            if (i >= nq) break;
            const bool fix = MX_FIX;
            AttnP p{};
            if (i < 64 || (i >= 128 && i < 132)) {
                if (i < 64) { const int bh = q + 8 * (i >> 4), qt = i & 15, bl = bh >> 3, hh = bh & 7;
                    p.Q = Qb + ((size_t)bh * SEQ + qt * 256) * 96; p.ntiles = 68; p.O = P + (size_t)(bl * SEQ + qt * 256) * NP + PC_AMLA + hh * 64;
                    p.Kb = Kb + (size_t)bh * TALL * 96; p.Vb = Vb + (size_t)bh * TALL * 64; }
                else { const int bh = q + 8 * (i - 128), bl = bh >> 3, hh = bh & 7;
                    p.Q = Qc + (size_t)bh * CTXL * 96; p.ntiles = 4; p.O = P + (size_t)(MG_LAT + bl * CTXL) * NP + PC_AMLA + hh * 64;
                    p.Kb = Kb + (size_t)bh * TALL * 96; p.Vb = Vb + (size_t)bh * TALL * 64; }
                p.q_ld = 96; p.o_ld = NP; p.C = MX_CMLA;
                if (fix) attn_unit<0, true>(lds, p); else attn_unit<0, false>(lds, p);
            } else {
                p.q_ld = NP; p.o_ld = NP; p.C = MX_CNA;
                if (i < 128) { const int u = i - 64, bh = q + 8 * (u >> 4), rb = u & 15, bl = bh >> 3, hh = bh & 7, r0 = rb * 4;
                    p.Q = P + (size_t)(bl * SEQ + r0 * 64) * NP + PC_NAQ + hh * 64; p.O = P + (size_t)(bl * SEQ + r0 * 64) * NP + PC_NAQ + hh * 64; p.r0 = r0;
                    p.rlo = min(max(r0 - 4, 0), 56); const int rhi = min(max(r0 + 3 - 4, 0), 56) + 7; p.nb = rhi - p.rlo + 1; p.ntiles = p.nb + 4;
                    p.Kb = P + (size_t)(bl * SEQ) * NP + PC_NAK + hh * 64; p.Vb = P + (size_t)(bl * SEQ) * NP + PC_NAV + hh * 64;
                    p.Kc = P + (size_t)(MG_LAT + bl * CTXL) * NP + PC_NAK + hh * 64; p.Vc = P + (size_t)(MG_LAT + bl * CTXL) * NP + PC_NAV + hh * 64;
                    p.rpb = a->in[22] + (size_t)(l * 8 + hh) * 465; }
                else { const int bh = q + 8 * (i - 132), bl = bh >> 3, hh = bh & 7;
                    p.Q = P + (size_t)(MG_LAT + bl * CTXL) * NP + PC_NAQ + hh * 64; p.O = P + (size_t)(MG_LAT + bl * CTXL) * NP + PC_NAQ + hh * 64;
                    p.r0 = 0; p.rlo = 0; p.nb = 0; p.ntiles = 4;
                    p.Kc = P + (size_t)(MG_LAT + bl * CTXL) * NP + PC_NAK + hh * 64; p.Vc = P + (size_t)(MG_LAT + bl * CTXL) * NP + PC_NAV + hh * 64;
                    p.Kb = p.Kc; p.Vb = p.Vc; p.rpb = a->in[22] + (size_t)(l * 8 + hh) * 465; }
                if (fix) attn_unit<1, true>(lds, p); else attn_unit<1, false>(lds, p);
            }
        }
    }
    mlC_phase(lds, P, ws, HD0, HD1);
}

__global__ void __launch_bounds__(512, 2) fwd_kernel(Args a_unused) {
    KArgs a = (KArgs)__builtin_amdgcn_kernarg_segment_ptr();
    extern __shared__ __attribute__((aligned(16))) unsigned char lds_raw[];
    cg::grid_group grid = cg::this_grid();
    char* lds = (char*)lds_raw;
    LAS unsigned char* ldsl = (LAS unsigned char*)lds_raw;
    const int G = gridDim.x, bid = blockIdx.x;
    { volatile LAS unsigned* st0 = (volatile LAS unsigned*)(lds_raw + 140032); if (threadIdx.x == 0) { st0[0] = 0u; st0[1] = 0u; } }
    __syncthreads();
    const XcdBarrier xbar = xcd_barrier_post((unsigned*)(a->ws + WS_CTL) + 4096, (volatile LAS unsigned*)(lds_raw + 140032));
#define GSYNC() xcd_barrier(xbar)
    unsigned char* ws = a->ws;
#define mod ((float*)(ws + WS_MOD))
#define xctx ((float*)(ws + WS_XCTX))
#define Hb ((bf16_t*)(ws + WS_H))
#define P ((bf16_t*)(ws + WS_P))
#define H2 ((bf16_t*)(ws + WS_H2))
#define U ((bf16_t*)(ws + WS_U))
#define Tb ((bf16_t*)(ws + WS_T))
#define Qb ((bf16_t*)(ws + WS_Q))
#define Qcb ((bf16_t*)(ws + WS_QC))
#define Kb ((bf16_t*)(ws + WS_K))
#define Vb ((bf16_t*)(ws + WS_V))
#define HD0 ((bf16_t*)(ws + WS_HD0))
#define HD1 ((bf16_t*)(ws + WS_HD1))
    if (bid < 192) mod_item(lds, a, bid);
    if (bid == 255 || (G < 256 && bid == 0)) { for (int i = threadIdx.x; i < 512; i += 512) { const int pos = i >> 3, f = i & 7; float sn, cs; sincosf((float)pos * expf(-(float)f * 0.125f * 9.210340371976184f), &sn, &cs);
        float* rt = (float*)(ws + WS_ROPE); rt[2 * i] = cs; rt[2 * i + 1] = sn; } }
    wconv_range(lds, a, bid, WT_LAYER, G);
    grid.sync();

#pragma unroll 1
    for (int l = 0; l < DEPTH; ++l) {
        asm volatile("" : "+s"(ws));
        const bool want_ctx = (l < DEPTH - 1);
#define modl (mod + (size_t)l * 9 * 6 * D)
#define wb (ws + WS_W + (size_t)l * W_LAYER)
#define xin_lat ((l == 0) ? a->in[0] : (const float*)a->out)
#define xin_ctx ((l == 0) ? a->in[2] : (const float*)xctx)
#pragma unroll 1
        for (int g = 0; g < NGROUP; ++g) {
            asm volatile("" : "+s"(ws));
            norm_phase(xin_lat, xin_ctx, MG_LAT, MG, g * MG_LAT, g * MG_CTX, a->in[6] + l * D, modl, 0, D, Hb);
            GSYNC();
            if (want_ctx) { pg8::Gemm gm{Hb, D, (const bf16_t*)(wb + WO_IN), MG, NP, D}; pg8::StaticOrder S; S.init(MG, NP, G, bid);
              pg8::EpiStore E{P, NP, 0}; pg8::gemm_phase(ldsl, gm, S, E); }
            else { pg8::Gemm gm{Hb, D, (const bf16_t*)(wb + WO_IN), MG, NP, D}; pg8::CtxSkipOrder S; S.init(G, bid);
              pg8::EpiStore E{P, NP, 0}; pg8::gemm_phase(ldsl, gm, S, E); }
            if (l == 0 && bid >= 44) wconv_range(lds, a, WT_LAYER + g * (WT_LAYER / 2) + (bid - 44), WT_LAYER + (g + 1) * (WT_LAYER / 2), G - 44);
            GSYNC();
            { pg8::SplitOrder S; S.init(MG, TW, G, bid, 3); pg8::Gemm gm{P + PC_DQ, NP, (const bf16_t*)(wb + WO_UQ), MG, TW, 384, PC_DKV - PC_DQ, 0, 0};
              pg8::EpiStore E{Tb, TW, 0}; pg8::gemm_phase(ldsl, gm, S, E); }
            mlA_phase(lds, a, l, P, ws);
            GSYNC();
            prep_phase(a, l, want_ctx, P, Tb, Qb, Qcb, Kb, Vb, (const float*)(ws + WS_ROPE));
            mlB_phase(lds, ws);
            GSYNC();
            mixer_phase(lds, a, l, want_ctx, (unsigned*)(ws + WS_CTL) + (l * NGROUP + g) * 16, ws, P, Qb, Qcb, Kb, Vb, HD0, HD1);
            GSYNC();
            const int mrows = want_ctx ? MG : MG_LAT;
            mlcomb_phase(a, l, mrows, P, HD0, HD1);
            GSYNC();
            { pg8::MergeOrder S; S.init(mrows, D, G, bid);
              pg8::Gemm gm{P + PC_MLO, NP, (const bf16_t*)(wb + WO_MLWO), mrows, D, 512, PC_AMLA - PC_MLO, PC_NAQ - PC_MLO, D * 512};
              pg8::EpiMerge E{P}; pg8::gemm_phase(ldsl, gm, S, E); }
            GSYNC();
            { pg8::Gemm gm{P + PC_Z, NP, (const bf16_t*)(wb + WO_WOUT), mrows, D, D}; pg8::StaticOrder S; S.init(mrows, D, G, bid);
              pg8::EpiRes E{xin_lat, xin_ctx, a->out, xctx, modl, 2 * D, MG_LAT, g * MG_LAT, g * MG_CTX}; pg8::gemm_phase(ldsl, gm, S, E); }
            GSYNC();
        }
        const int frows = want_ctx ? M_ALL : M_LAT;
        norm_phase(a->out, xctx, M_LAT, frows, 0, 0, a->in[7] + l * D, modl, 3 * D, 4 * D, H2);
        GSYNC();
        { pg8::Gemm gm{H2, D, (const bf16_t*)(wb + WO_FF1), frows, DFF, D}; pg8::StaticOrder S; S.init(frows, DFF, G, bid);
          pg8::EpiStore E{U, DFF, 1}; pg8::gemm_phase(ldsl, gm, S, E); }
        GSYNC();
        { pg8::Gemm gm{U, DFF, (const bf16_t*)(wb + WO_FF2), frows, D, DFF}; pg8::StaticOrder S; S.init(frows, D, G, bid);
          pg8::EpiRes E{a->out, xctx, a->out, xctx, modl, 5 * D, M_LAT, 0, 0}; pg8::gemm_phase(ldsl, gm, S, E); }
        GSYNC();
    }
}

extern "C" void kernel_launch(void* const* d_in, const int* in_sizes, int n_in, void* d_out, int out_size, void* d_ws, size_t ws_size, hipStream_t stream) {
    static int grid = 0;
    if (grid == 0) {
        if (n_in != 27 || in_sizes[0] != M_LAT * D || out_size != M_LAT * D || ws_size < 512 * MiB) {
            fprintf(stderr, "kernel_launch: unexpected shapes (n_in %d, in0 %d, out %d, ws %zu); nothing launched\n", n_in, n_in > 0 ? in_sizes[0] : -1, out_size, ws_size); grid = -1; return; }
        int dev = 0, cus = 0, per_cu = 0;
        hipGetDevice(&dev); hipDeviceGetAttribute(&cus, hipDeviceAttributeMultiprocessorCount, dev);
        if (hipFuncSetAttribute((const void*)fwd_kernel, hipFuncAttributeMaxDynamicSharedMemorySize, LDS_BYTES) != hipSuccess) { fprintf(stderr, "hipFuncSetAttribute failed\n"); grid = -1; return; }
        hipOccupancyMaxActiveBlocksPerMultiprocessor(&per_cu, (const void*)fwd_kernel, 512, LDS_BYTES);
        if (per_cu < 1) { fprintf(stderr, "occupancy query says %d blocks/CU\n", per_cu); per_cu = 1; }
        (void)hipGetLastError();
        grid = cus;
    }
    if (grid < 0) return;
    (void)hipMemsetAsync((char*)d_ws + WS_CTL, 0, 65536, stream);
    Args a{};
    for (int i = 0; i < 27; ++i) a.in[i] = (const float*)d_in[i];
    a.out = (float*)d_out; a.ws = (unsigned char*)d_ws;
    void* args[] = {&a};
    hipError_t e = hipLaunchCooperativeKernel((const void*)fwd_kernel, dim3(grid), dim3(512), args, LDS_BYTES, stream);
    if (e != hipSuccess) fprintf(stderr, "cooperative launch failed: %s (grid %d)\n", hipGetErrorString(e), grid);
}
```

```cpp
#include <hip/hip_runtime.h>
#include <hip/hip_cooperative_groups.h>
#include <cstdio>
#include <cstdint>
namespace cg = cooperative_groups;

#define DI __device__ __forceinline__
#define LAS __attribute__((address_space(3)))
typedef unsigned short bf16_t;
typedef short bf16x8 __attribute__((ext_vector_type(8)));
typedef float f32x4 __attribute__((ext_vector_type(4)));
typedef float f32x16 __attribute__((ext_vector_type(16)));
typedef float f32x2_t __attribute__((ext_vector_type(2)));
typedef __bf16 bf16x2_t __attribute__((ext_vector_type(2)));
typedef unsigned u32x4 __attribute__((ext_vector_type(4)));
typedef unsigned u32x2 __attribute__((ext_vector_type(2)));

constexpr int D = 1024, NBATCH = 8, SEQ = 4096, CTXL = 256, DFF = 4096, DEPTH = 2;
constexpr int GB = 4, NGROUP = 2;
constexpr int MG_LAT = GB * SEQ, MG_CTX = GB * CTXL, MG = MG_LAT + MG_CTX;
constexpr int M_LAT = NBATCH * SEQ, M_CTX = NBATCH * CTXL, M_ALL = M_LAT + M_CTX;
constexpr int D_IN = 6832, NP = 6912;
constexpr int TALL = CTXL + SEQ;
constexpr int PC_MLQ = 0, PC_MLK = 256, PC_MLV = 512, PC_MLO = 1024, PC_NAQ = 1536, PC_NAK = 2048, PC_NAV = 2560,
              PC_DQ = 3072, PC_DKV = 3456, PC_KR = 3712, PC_GT = 3744, PC_MG = 3840;
constexpr int PC_AMLA = 3072, PC_Z = 2048;
constexpr int TW = 1792;
constexpr float EPS = 1e-6f;
constexpr float LOG2E = 1.4426950408889634f;

constexpr size_t MiB = 1u << 20;
constexpr size_t WS_CTL = 0, WS_ROPE = 512 * 1024, WS_MOD = 1 * MiB, WS_W = 2 * MiB, W_LAYER = 36 * MiB;
constexpr size_t WO_IN = 0, WO_MLWO = 13 * MiB + 512 * 1024, WO_MLAWO = WO_MLWO + 1 * MiB, WO_NAWO = WO_MLAWO + 1 * MiB, WO_UQ = WO_NAWO + 1 * MiB, WO_UKV = WO_UQ + 576 * 1024,
                 WO_WOUT = WO_UKV + 768 * 1024, WO_FF1 = WO_WOUT + 2 * MiB, WO_FF2 = WO_FF1 + 8 * MiB;
static_assert(WO_FF2 + 8 * MiB <= W_LAYER, "weights");
constexpr size_t WS_XCTX = 74 * MiB, WS_QC = 82 * MiB, WS_REG = 84 * MiB;
constexpr size_t WS_H = WS_REG, WS_P = 118 * MiB, WS_Q = 348 * MiB, WS_K = 372 * MiB, WS_V = 398 * MiB, WS_HD0 = 415 * MiB, WS_HD1 = 432 * MiB, WS_T = 415 * MiB;
constexpr size_t WS_ANA = 450 * MiB;
constexpr size_t WS_PART = 424 * MiB;
constexpr size_t WS_H2 = WS_REG, WS_U = 152 * MiB;
constexpr size_t WS_END = 511 * MiB;
static_assert(WS_P + (size_t)MG * NP * 2 <= WS_Q && WS_T + (size_t)MG * TW * 2 <= WS_END && WS_U + (size_t)M_ALL * DFF * 2 <= WS_END, "ws map");

constexpr int LDS_BYTES = 147456;

DI unsigned pk2(float lo, float hi) { f32x2_t v = {lo, hi}; bf16x2_t b = __builtin_convertvector(v, bf16x2_t); return __builtin_bit_cast(unsigned, b); }
DI bf16_t f2bf(float f) { return (bf16_t)(pk2(f, 0.f) & 0xffffu); }
DI float bf2f(bf16_t v) { return __uint_as_float(((unsigned)v) << 16); }
DI float bflo(unsigned w) { return __uint_as_float(w << 16); }
DI float bfhi(unsigned w) { return __uint_as_float(w & 0xffff0000u); }
template <int CTRL> DI float dpp_f(float v) { return __int_as_float(__builtin_amdgcn_update_dpp(0, __float_as_int(v), CTRL, 0xF, 0xF, true)); }
DI float sum4(float v) { v += dpp_f<0xB1>(v); v += dpp_f<0x4E>(v); return v; }
DI float sum8(float v) { v = sum4(v); v += dpp_f<0x141>(v); return v; }
DI float sum16(float v) { v = sum8(v); v += dpp_f<0x140>(v); return v; }
DI float wave_sum(float v) {
    v = sum16(v);
    const int iv = __float_as_int(v);
    return (__int_as_float(__builtin_amdgcn_readlane(iv, 0)) + __int_as_float(__builtin_amdgcn_readlane(iv, 16))) + (__int_as_float(__builtin_amdgcn_readlane(iv, 32)) + __int_as_float(__builtin_amdgcn_readlane(iv, 48)));
}
DI float shx(float v, int lane, int m) { return __int_as_float(__builtin_amdgcn_ds_bpermute((lane ^ m) << 2, __float_as_int(v))); }
DI float shu(float v, int lane, int d) { return __int_as_float(__builtin_amdgcn_ds_bpermute(((lane - d) & 63) << 2, __float_as_int(v))); }
DI float rdl63(float v) { return __int_as_float(__builtin_amdgcn_readlane(__float_as_int(v), 63)); }
DI float sigmoidf_(float x) { return __builtin_amdgcn_rcpf(1.f + __expf(-x)); }

namespace pg8 {
constexpr int BM = 256, BK = 64, HALF = 128, HTB = HALF * BK * 2, NXCD = 8, WGM = 8;
DI int lds_byte(int r, int c) { const int st = (r >> 4) * 2 + (c >> 5), rr = r & 15, cc = c & 31, ob = rr * 64 + cc * 2; return st * 1024 + (ob ^ (((ob >> 9) & 1) << 5)); }
DI void stage_rc(int b, int& R, int& C) { const int st = b / 1024, sb = b % 1024, swz = sb ^ (((sb >> 9) & 1) << 5); R = (st >> 1) * 16 + swz / 64; C = (st & 1) * 32 + (swz % 64) / 2; }
DI int perm32(int rho) { const int n = rho >> 4, i = rho & 15; return 8 * (i >> 2) + 4 * n + (i & 3); }
struct Unit { int pm, pn, br; };
struct Gemm { const bf16_t* A; int lda; const bf16_t* Bt; int M, N, K; int a1 = 0, a2 = 0; int bbr = 0; int ldb = 0; };
struct StaticOrder {
    int nM, nN, nwg, G, c;
    DI void init(int M, int N, int G_, int c_) { nM = M / BM; nN = N / BM; nwg = nM * nN; G = G_; c = c_; }
    DI bool next(int i, Unit& u) const {
        const long L = (long)i * G + c; if (L >= nwg) return false;
        int wgid = (int)L; { const int q = nwg / NXCD, r = nwg % NXCD, xcd = wgid % NXCD, off = wgid / NXCD; wgid = (xcd < r ? xcd * (q + 1) : r * (q + 1) + (xcd - r) * q) + off; }
        const int nig = WGM * nN, gid = wgid / nig, fm = gid * WGM, gsz = (nM - fm) < WGM ? (nM - fm) : WGM;
        u.pm = fm + ((wgid % nig) % gsz); u.pn = (wgid % nig) / gsz; u.br = 0; return true;
    }
    DI bool keep(const Unit&) const { return false; }
};
struct CtxSkipOrder {
    StaticOrder T; int G, c;
    DI void init(int G_, int c_) { T.init(MG_LAT, NP, G_, c_); G = G_; c = c_; }
    DI bool next(int i, Unit& u) const {
        const int L = i * G + c;
        if (L < 64 * 27) return T.next(i, u);
        const int x = L - 64 * 27; if (x >= 36) return false;
        const int q = x / 9, k = x - 9 * q;
        u.pm = 64 + q; u.pn = (k < 3) ? 1 + k : (k < 7 ? 5 + k : 6 + k); u.br = 0; return true;
    }
    DI bool keep(const Unit&) const { return false; }
};
struct SplitOrder {
    StaticOrder T; int split;
    DI void init(int M, int N, int G_, int c_, int split_) { T.init(M, N, G_, c_); split = split_; }
    DI bool next(int i, Unit& u) const { if (!T.next(i, u)) return false; u.br = (u.pn >= split) ? 1 : 0; return true; }
    DI bool keep(const Unit&) const { return false; }
};
struct MergeOrder {
    StaticOrder T;
    DI void init(int M, int N, int G_, int c_) { T.init(M, N, G_, c_); }
    DI bool next(int i, Unit& u) const { const int t = i / 3; if (!T.next(t, u)) return false; u.br = i - 3 * t; return true; }
    DI bool keep(const Unit& u) const { return u.br < 2; }
};
#define PG8_ABASE(u) ((const char*)g.A + (size_t)(u).pm * tstepA + (size_t)((u).br == 0 ? 0 : ((u).br == 1 ? g.a1 : g.a2)) * 2)
#define PG8_BBASE(u) ((const char*)g.Bt + (size_t)(u).pn * tstepB + (size_t)(u).br * g.bbr * 2)
template <class Epi, class Sched>
DI void gemm_phase(LAS unsigned char* lds, const Gemm g, const Sched& S, const Epi& E) {
    int tid = threadIdx.x; asm volatile("" : "+v"(tid));
    const int wid = __builtin_amdgcn_readfirstlane(tid >> 6), lane = tid & 63, wr = wid >> 2, wc = wid & 3, fr = lane & 15, fq = lane >> 4;
    const int K = g.K, nt = K / BK, lda = g.lda, ldb = g.ldb ? g.ldb : g.K;
    unsigned voffA[2], voffB[2];
#pragma unroll
    for (int i = 0; i < 2; ++i) { int R, C; stage_rc(tid * 16 + i * 8192, R, C); const int Rb = (R & ~31) + perm32(R & 31);
        voffA[i] = (unsigned)(R * lda + C) * 2u; voffB[i] = (unsigned)(Rb * ldb + C) * 2u; }
    const size_t kstep = (size_t)(BK * 2);
    const size_t hstepA = (size_t)HALF * lda * 2, hstepB = (size_t)HALF * ldb * 2;
    const size_t tstepA = 2 * hstepA, tstepB = 2 * hstepB;
    const unsigned ldsw = (unsigned)wid * 1024u;
    const int aoff = lds_byte(wr * 64 + fr, fq * 8), boff = lds_byte(wc * 32 + fr, fq * 8);
#define PG8_SA(b, h) (((b) * 2 + (h)) * HTB)
#define PG8_SB(b, h) ((4 + (b) * 2 + (h)) * HTB)
#define PG8_STAGE(bufoff, gbase, voff) do { _Pragma("unroll") for (int _i = 0; _i < 2; ++_i) \
        __builtin_amdgcn_global_load_lds((const unsigned*)((const char*)(gbase) + (voff)[_i]), (LAS unsigned*)(lds + (bufoff) + ldsw + _i * 8192), 16, 0, 0); } while (0)
#define PG8_LDA(dst, b, h) do { _Pragma("unroll") for (int m = 0; m < 4; ++m) _Pragma("unroll") for (int k = 0; k < 2; ++k) dst[m][k] = *(const LAS bf16x8*)(lds + PG8_SA(b, h) + aoff + m * 2048 + k * 1024); } while (0)
#define PG8_LDB(dst, b, h) do { _Pragma("unroll") for (int n = 0; n < 2; ++n) _Pragma("unroll") for (int k = 0; k < 2; ++k) dst[n][k] = *(const LAS bf16x8*)(lds + PG8_SB(b, h) + boff + n * 2048 + k * 1024); } while (0)
#define PG8_MMA(ai, bj, At, Bt) do { __builtin_amdgcn_s_setprio(1); _Pragma("unroll") for (int m = 0; m < 4; ++m) _Pragma("unroll") for (int n = 0; n < 2; ++n) _Pragma("unroll") for (int k = 0; k < 2; ++k) \
        acc[ai][bj][m][n] = __builtin_amdgcn_mfma_f32_16x16x32_bf16(Bt[n][k], At[m][k], acc[ai][bj][m][n], 0, 0, 0); __builtin_amdgcn_s_setprio(0); } while (0)
#define PG8_WAIT_V(n) asm volatile("s_waitcnt vmcnt(" #n ")" ::: "memory")
#define PG8_WAIT_L(n) asm volatile("s_waitcnt lgkmcnt(" #n ")" ::: "memory")
#define PG8_BAR __builtin_amdgcn_s_barrier()
#define PG8_SCHED __builtin_amdgcn_sched_barrier(0)
    Unit cur, nxt; int ui = 0;
    if (!S.next(0, cur)) return;
    f32x4 acc[2][2][4][2];
#pragma unroll
    for (int a = 0; a < 2; ++a)
#pragma unroll
        for (int b = 0; b < 2; ++b)
#pragma unroll
            for (int m = 0; m < 4; ++m)
#pragma unroll
                for (int n = 0; n < 2; ++n) acc[a][b][m][n] = (f32x4){0.f, 0.f, 0.f, 0.f};
    bf16x8 At[4][2], B0[2][2], B1[2][2];
    const char* cA = PG8_ABASE(cur); const char* cB = PG8_BBASE(cur);
    PG8_STAGE(PG8_SB(0, 0), cB, voffB); PG8_STAGE(PG8_SB(0, 1), cB + hstepB, voffB); PG8_STAGE(PG8_SA(0, 0), cA, voffA); PG8_STAGE(PG8_SA(0, 1), cA + hstepA, voffA);
    if (wr == 1) PG8_BAR;
    PG8_WAIT_V(2); PG8_BAR;
    PG8_STAGE(PG8_SB(1, 0), cB + kstep, voffB); PG8_STAGE(PG8_SA(1, 0), cA + kstep, voffA); PG8_STAGE(PG8_SB(1, 1), cB + hstepB + kstep, voffB);
    PG8_WAIT_V(6); PG8_BAR;
    for (;;) {
        const bool has_next = S.next(ui + 1, nxt);
        const char* nA = has_next ? PG8_ABASE(nxt) : cA; const char* nB = has_next ? PG8_BBASE(nxt) : cB;
        for (int t = 0; t < nt; t += 2) {
            const bool last = (t == nt - 2);
            const char* a1 = cA + (size_t)(t + 1) * kstep;
            const char* a2 = last ? nA : cA + (size_t)(t + 2) * kstep; const char* b2 = last ? nB : cB + (size_t)(t + 2) * kstep;
            const char* a3 = a2 + kstep; const char* b3 = b2 + kstep;
            PG8_LDB(B0, 0, 0); PG8_LDB(B1, 0, 1); PG8_SCHED; PG8_LDA(At, 0, 0); PG8_STAGE(PG8_SA(1, 1), a1 + hstepA, voffA);
            PG8_WAIT_V(8); PG8_WAIT_L(0); PG8_BAR; PG8_MMA(0, 0, At, B0); PG8_MMA(0, 1, At, B1); PG8_BAR; PG8_SCHED;
            PG8_LDA(At, 0, 1); PG8_STAGE(PG8_SB(0, 0), b2, voffB); PG8_STAGE(PG8_SB(0, 1), b2 + hstepB, voffB); PG8_STAGE(PG8_SA(0, 0), a2, voffA);
            PG8_WAIT_V(8); PG8_WAIT_L(0); PG8_BAR; PG8_MMA(1, 0, At, B0); PG8_MMA(1, 1, At, B1); PG8_BAR; PG8_SCHED;
            PG8_LDB(B0, 1, 0); PG8_LDB(B1, 1, 1); PG8_SCHED; PG8_LDA(At, 1, 0); PG8_STAGE(PG8_SA(0, 1), a2 + hstepA, voffA);
            PG8_WAIT_V(8); PG8_WAIT_L(0); PG8_BAR; PG8_MMA(0, 0, At, B0); PG8_MMA(0, 1, At, B1); PG8_BAR; PG8_SCHED;
            PG8_LDA(At, 1, 1); PG8_STAGE(PG8_SB(1, 0), b3, voffB); PG8_STAGE(PG8_SB(1, 1), b3 + hstepB, voffB); PG8_STAGE(PG8_SA(1, 0), a3, voffA);
            PG8_WAIT_V(8); PG8_WAIT_L(0); PG8_BAR; PG8_MMA(1, 0, At, B0); PG8_MMA(1, 1, At, B1); PG8_BAR; PG8_SCHED;
        }
        if (wr == 0) PG8_BAR;
        { int t2 = threadIdx.x; asm volatile("" : "+v"(t2)); E(acc, cur, wr, wc, t2 & 15, (t2 & 63) >> 4); }
        if (!has_next) break;
        if (!S.keep(cur)) {
#pragma unroll
        for (int a = 0; a < 2; ++a)
#pragma unroll
            for (int b = 0; b < 2; ++b)
#pragma unroll
                for (int m = 0; m < 4; ++m)
#pragma unroll
                    for (int n = 0; n < 2; ++n) acc[a][b][m][n] = (f32x4){0.f, 0.f, 0.f, 0.f};
        }
        cur = nxt; cA = nA; cB = nB; ++ui;
        if (wr == 1) PG8_BAR;
    }
    PG8_WAIT_V(0);
    PG8_BAR;
#undef PG8_SA
#undef PG8_SB
#undef PG8_STAGE
#undef PG8_LDA
#undef PG8_LDB
#undef PG8_MMA
#undef PG8_WAIT_V
#undef PG8_WAIT_L
#undef PG8_BAR
#undef PG8_SCHED
}

struct EpiStore {
    bf16_t* O; int ldc; int act;
    DI void operator()(const f32x4 (&acc)[2][2][4][2], const Unit& u, int wr, int wc, int fr, int fq) const {
        const int row0 = u.pm * BM + wr * 64 + fr, col0 = u.pn * BM + wc * 32 + 8 * fq;
#pragma unroll
        for (int ai = 0; ai < 2; ++ai)
#pragma unroll
            for (int m = 0; m < 4; ++m) { bf16_t* rowp = O + (size_t)(row0 + ai * HALF + m * 16) * ldc + col0;
#pragma unroll
                for (int bj = 0; bj < 2; ++bj) { f32x4 v0 = acc[ai][bj][m][0], v1 = acc[ai][bj][m][1];
                    if (act == 1) {
#pragma unroll
                        for (int j = 0; j < 4; ++j) { float a = fmaxf(v0[j], 0.f), b = fmaxf(v1[j], 0.f); v0[j] = a * a; v1[j] = b * b; } }
                    u32x4 w; w.x = pk2(v0[0], v0[1]); w.y = pk2(v0[2], v0[3]); w.z = pk2(v1[0], v1[1]); w.w = pk2(v1[2], v1[3]);
                    *(u32x4*)(rowp + bj * HALF) = w; } }
    }
};
struct EpiMerge {
    bf16_t* P;
    DI void operator()(f32x4 (&acc)[2][2][4][2], const Unit& u, int wr, int wc, int fr, int fq) const {
        const int row0 = u.pm * BM + wr * 64 + fr, col0 = u.pn * BM + wc * 32 + 8 * fq;
        const int gc = PC_MG + u.br * D;
#pragma unroll
        for (int ai = 0; ai < 2; ++ai)
#pragma unroll
            for (int m = 0; m < 4; ++m) { bf16_t* rowp = P + (size_t)(row0 + ai * HALF + m * 16) * NP;
#pragma unroll
                for (int bj = 0; bj < 2; ++bj) { const int c = col0 + bj * HALF;
                    const u32x4 ga = *(const u32x4*)(rowp + gc + c);
                    float xa[8]; xa[0] = bflo(ga.x); xa[1] = bfhi(ga.x); xa[2] = bflo(ga.y); xa[3] = bfhi(ga.y); xa[4] = bflo(ga.z); xa[5] = bfhi(ga.z); xa[6] = bflo(ga.w); xa[7] = bfhi(ga.w);
                    f32x4& v0 = acc[ai][bj][m][0]; f32x4& v1 = acc[ai][bj][m][1];
                    if (u.br < 2) {
                        const u32x4 gb = *(const u32x4*)(rowp + gc + D + c);
                        float xb[8]; xb[0] = bflo(gb.x); xb[1] = bfhi(gb.x); xb[2] = bflo(gb.y); xb[3] = bfhi(gb.y); xb[4] = bflo(gb.z); xb[5] = bfhi(gb.z); xb[6] = bflo(gb.w); xb[7] = bfhi(gb.w);
#pragma unroll
                        for (int j = 0; j < 4; ++j) { v0[j] *= (1.f + __expf(-xb[j])) * __builtin_amdgcn_rcpf(1.f + __expf(-xa[j])); v1[j] *= (1.f + __expf(-xb[4 + j])) * __builtin_amdgcn_rcpf(1.f + __expf(-xa[4 + j])); }
                    } else {
                        u32x4 w; w.x = pk2(v0[0] * sigmoidf_(xa[0]), v0[1] * sigmoidf_(xa[1])); w.y = pk2(v0[2] * sigmoidf_(xa[2]), v0[3] * sigmoidf_(xa[3]));
                        w.z = pk2(v1[0] * sigmoidf_(xa[4]), v1[1] * sigmoidf_(xa[5])); w.w = pk2(v1[2] * sigmoidf_(xa[6]), v1[3] * sigmoidf_(xa[7]));
                        *(u32x4*)(rowp + PC_Z + c) = w;
                    } } }
    }
};
struct EpiRes {
    const float* src_lat; const float* src_ctx; float* dst_lat; float* dst_ctx; const float* modl; int goff; int nlat, latoff, ctxoff;
    DI void operator()(const f32x4 (&acc)[2][2][4][2], const Unit& u, int wr, int wc, int fr, int fq) const {
        const int row0 = u.pm * BM + wr * 64 + fr, col0 = u.pn * BM + wc * 32 + 8 * fq;
        const int trow = u.pm * BM;
        const bool lat = trow < nlat;
        const int b = lat ? (latoff + trow) / SEQ : NBATCH;
        const float* gate = modl + (size_t)b * 6 * D + goff;
        const float* sb = lat ? src_lat + (long)latoff * D : src_ctx + ((long)ctxoff - nlat) * D;
        float* db = lat ? dst_lat + (long)latoff * D : dst_ctx + ((long)ctxoff - nlat) * D;
        f32x4 gv[2][2];
#pragma unroll
        for (int bj = 0; bj < 2; ++bj)
#pragma unroll
            for (int n = 0; n < 2; ++n) gv[bj][n] = *(const f32x4*)(gate + col0 + bj * HALF + 4 * n);
#pragma unroll
        for (int ai = 0; ai < 2; ++ai)
#pragma unroll
            for (int m = 0; m < 4; ++m) { const size_t ro = (size_t)(row0 + ai * HALF + m * 16) * D + col0;
#pragma unroll
                for (int bj = 0; bj < 2; ++bj)
#pragma unroll
                    for (int n = 0; n < 2; ++n) { const f32x4 s = *(const f32x4*)(sb + ro + bj * HALF + 4 * n);
                        *(f32x4*)(db + ro + bj * HALF + 4 * n) = s + gv[bj][n] * acc[ai][bj][m][n]; } }
    }
};
struct EpiPartial {
    float* dst;
    DI void operator()(const f32x4 (&acc)[2][2][4][2], const Unit& u, int wr, int wc, int fr, int fq) const {
        const int row0 = u.pm * BM + wr * 64 + fr, col0 = u.pn * BM + wc * 32 + 8 * fq;
#pragma unroll
        for (int ai = 0; ai < 2; ++ai)
#pragma unroll
            for (int m = 0; m < 4; ++m) { float* rp = dst + (size_t)(row0 + ai * HALF + m * 16) * D + col0;
#pragma unroll
                for (int bj = 0; bj < 2; ++bj)
#pragma unroll
                    for (int n = 0; n < 2; ++n) *(f32x4*)(rp + bj * HALF + 4 * n) = acc[ai][bj][m][n]; }
    }
};
}


#define XB_TMO      128
#define XB_XCNT(j)  (256  + 64 * (j))
#define XB_XSUB(j)  (1280 + 64 * (j))
#define XB_XGEN(j)  (2304 + 64 * (j))
#define XB_TOP      3328
#define XB_TOPGEN   3392
#define XCD_BAR_WORDS 3456
#define XB_SPIN_CAP (1u << 22)
DI unsigned xb_ld(unsigned* p)              { return __hip_atomic_load(p, __ATOMIC_RELAXED, __HIP_MEMORY_SCOPE_AGENT); }
DI unsigned xb_add(unsigned* p, unsigned v) { return __hip_atomic_fetch_add(p, v, __ATOMIC_RELAXED, __HIP_MEMORY_SCOPE_AGENT); }
DI unsigned xb_xcc_id() { return (unsigned)__builtin_amdgcn_s_getreg((3 << 11) | 20) & 0xFu; }
#define XB_SPIN(cond, bar) do { unsigned _sp = 0; while (cond) { __builtin_amdgcn_s_sleep(1); \
    if ((++_sp & 255u) == 0u) { if (xb_ld(&(bar)[XB_TMO])) break; if (_sp > XB_SPIN_CAP) { atomicAdd(&(bar)[XB_TMO], 1u); break; } } } } while (0)
struct XcdBarrier { unsigned* bar; unsigned x; volatile LAS unsigned* st; };
DI XcdBarrier xcd_barrier_post(unsigned* bar, volatile LAS unsigned* st) {
    XcdBarrier b; b.bar = bar; b.x = xb_xcc_id(); b.st = st;
    if (threadIdx.x == 0) (void)xb_add(&bar[XB_XCNT(b.x)], 1u);
    return b;
}
DI void xcd_barrier_complete(unsigned* bar, unsigned x, unsigned& nloc, unsigned& nx) {
    const unsigned G = gridDim.x * gridDim.y * gridDim.z;
    unsigned sum, cnt, mine, sp = 0u;
    for (;;) {
        sum = 0u; cnt = 0u; mine = 0u;
#pragma unroll
        for (unsigned j = 0; j < 16; ++j) { const unsigned c = xb_ld(&bar[XB_XCNT(j)]); sum += c; cnt += (c > 0u) ? 1u : 0u; mine = (j == x) ? c : mine; }
        if (sum == G) break;
        __builtin_amdgcn_s_sleep(1);
        if ((++sp & 255u) == 0u) { if (xb_ld(&bar[XB_TMO])) break; if (sp > XB_SPIN_CAP) { atomicAdd(&bar[XB_TMO], 1u); break; } }
    }
    nloc = mine > 0u ? mine : 1u; nx = cnt > 0u ? cnt : 1u;
}
DI void xcd_barrier(const XcdBarrier& b) {
    asm volatile("s_waitcnt vmcnt(0)" ::: "memory");
    __syncthreads();
    if (threadIdx.x == 0) {
        unsigned* bar = b.bar;
        __builtin_amdgcn_s_waitcnt(0);
        unsigned nloc = b.st[0], nx = b.st[1];
        if (nloc == 0u) { xcd_barrier_complete(bar, b.x, nloc, nx); b.st[0] = nloc; b.st[1] = nx; }
        const unsigned old = xb_add(&bar[XB_XSUB(b.x)], 1u);
        const unsigned gen = old / nloc;
        if (old + 1u == (gen + 1u) * nloc) {
            __builtin_amdgcn_fence(__ATOMIC_RELEASE, "agent");
            asm volatile("s_waitcnt vmcnt(0)" ::: "memory");
            const unsigned og = xb_add(&bar[XB_TOP], 1u);
            const unsigned tg = og / nx;
            if (og + 1u == (tg + 1u) * nx) xb_add(&bar[XB_TOPGEN], 1u);
            else XB_SPIN(xb_ld(&bar[XB_TOPGEN]) == tg, bar);
            __builtin_amdgcn_fence(__ATOMIC_ACQUIRE, "agent");
            xb_add(&bar[XB_XGEN(b.x)], 1u);
            asm volatile("s_waitcnt vmcnt(0)" ::: "memory");
        } else {
            XB_SPIN(xb_ld(&bar[XB_XGEN(b.x)]) == gen, bar);
            __builtin_amdgcn_fence(__ATOMIC_ACQUIRE, "agent");
            asm volatile("s_waitcnt vmcnt(0)" ::: "memory");
        }
    }
    __syncthreads();
}

struct Args {
    const float* in[27];
    float* out; unsigned char* ws;
};
typedef const __attribute__((address_space(4))) Args* KArgs;

DI int win_src_col(int np) {
    if (np < 1536) return np;
    if (np < 3072) return np + 688;
    if (np < 3744) return np - 3072 + 1552;
    if (np < 3760) return np - 3744 + 1536;
    if (np < 3840) return -1;
    return np - 80;
}
struct WJob { const float* src; bf16_t* dst; const float* rs; int K, N, kt, nt, mode; };
DI void wconv_load(const WJob& j, float (&v)[8]) {
    int tid = threadIdx.x; asm volatile("" : "+v"(tid));
    const int nl = tid & 63, ks = tid >> 6;
    const int np = j.nt * 64 + nl;
    const int sc = (j.mode == 1) ? win_src_col(np) : np;
#pragma unroll
    for (int kk = 0; kk < 8; ++kk) { const int k = j.kt * 64 + ks * 8 + kk; float x = 0.f;
        if (j.mode == 2) { v[kk] = 0.f; continue; }
        if (sc >= 0) x = j.src[(size_t)k * j.N + sc];
        if (j.rs) x *= j.rs[k];
        v[kk] = x; }
}
DI void wconv_store(char* lds, const WJob& j, const float (&v)[8]) {
    float* tile = (float*)lds;
    int tid = threadIdx.x; asm volatile("" : "+v"(tid));
    const int nl = tid & 63, ks = tid >> 6;
    __syncthreads();
#pragma unroll
    for (int kk = 0; kk < 8; ++kk) tile[(ks * 8 + kk) * 65 + nl] = v[kk];
    __syncthreads();
    const int n2 = tid >> 3, kseg = tid & 7;
    float o[8];
#pragma unroll
    for (int q = 0; q < 8; ++q) o[q] = tile[(kseg * 8 + q) * 65 + n2];
    u32x4 w; w.x = pk2(o[0], o[1]); w.y = pk2(o[2], o[3]); w.z = pk2(o[4], o[5]); w.w = pk2(o[6], o[7]);
    *(u32x4*)(j.dst + (size_t)(j.nt * 64 + n2) * j.K + j.kt * 64 + kseg * 8) = w;
}
constexpr int WT_IN = 108 * 16, WT_MLWO = 16 * 8, WT_UQ = 12 * 6, WT_UKV = 16 * 6, WT_MLAWO = 16 * 8, WT_NAWO = 16 * 8, WT_WOUT = 16 * 16, WT_FF1 = 64 * 16, WT_FF2 = 16 * 64;
constexpr int WT_LAYER = WT_IN + WT_MLWO + WT_UQ + WT_UKV + WT_MLAWO + WT_NAWO + WT_WOUT + WT_FF1 + WT_FF2;
DI WJob wconv_decode(KArgs a, int item) {
    const int l = item / WT_LAYER; int r = item % WT_LAYER;
    unsigned char* wb = a->ws + WS_W + (size_t)l * W_LAYER;
    WJob j; j.mode = 0; j.rs = nullptr; int NT;
    if (r < WT_IN) { j.src = a->in[8] + (size_t)l * D * D_IN; j.dst = (bf16_t*)(wb + WO_IN); j.K = D; j.N = D_IN; NT = 108; j.mode = 1; }
    else if ((r -= WT_IN) < WT_MLWO) { j.src = a->in[12] + (size_t)l * 512 * D; j.dst = (bf16_t*)(wb + WO_MLWO); j.K = 512; j.N = D; NT = 16; }
    else if ((r -= WT_MLWO) < WT_UQ) { j.src = a->in[14] + (size_t)l * 384 * 768; j.dst = (bf16_t*)(wb + WO_UQ); j.K = 384; j.N = 768; NT = 12; j.rs = a->in[13] + l * 384; }
    else if ((r -= WT_UQ) < WT_UKV) { j.src = a->in[16] + (size_t)l * 256 * 1024; j.dst = (bf16_t*)(wb + WO_UKV); j.K = 384; j.N = 1024; NT = 16; j.rs = a->in[15] + l * 256; if (r >= 16 * 4) j.mode = 2; }
    else if ((r -= WT_UKV) < WT_MLAWO) { j.src = a->in[19] + (size_t)l * 512 * D; j.dst = (bf16_t*)(wb + WO_MLAWO); j.K = 512; j.N = D; NT = 16; }
    else if ((r -= WT_MLAWO) < WT_NAWO) { j.src = a->in[23] + (size_t)l * 512 * D; j.dst = (bf16_t*)(wb + WO_NAWO); j.K = 512; j.N = D; NT = 16; }
    else if ((r -= WT_NAWO) < WT_WOUT) { j.src = a->in[24] + (size_t)l * D * D; j.dst = (bf16_t*)(wb + WO_WOUT); j.K = D; j.N = D; NT = 16; }
    else if ((r -= WT_WOUT) < WT_FF1) { j.src = a->in[25] + (size_t)l * D * DFF; j.dst = (bf16_t*)(wb + WO_FF1); j.K = D; j.N = DFF; NT = 64; }
    else { r -= WT_FF1; j.src = a->in[26] + (size_t)l * DFF * D; j.dst = (bf16_t*)(wb + WO_FF2); j.K = DFF; j.N = D; NT = 16; }
    j.nt = r % NT; j.kt = r / NT;
    return j;
}
DI void wconv_range(char* lds, KArgs a, int first, int last, int stride) {
    int it = first; float v[8];
    if (it < last) { const WJob j = wconv_decode(a, it); wconv_load(j, v); }
    while (it < last) {
        const WJob j = wconv_decode(a, it);
        const int nx = it + stride; float v2[8];
#pragma unroll
        for (int q = 0; q < 8; ++q) v2[q] = 0.f;
        if (nx < last) { const WJob jn = wconv_decode(a, nx); wconv_load(jn, v2); }
        wconv_store(lds, j, v);
#pragma unroll
        for (int q = 0; q < 8; ++q) v[q] = v2[q];
        it = nx;
    }
    __syncthreads();
}
DI void mod_item(char* lds, KArgs a, int item) {
    float* sv = (float*)lds;
    float* red = sv + 9 * 1024;
    const int tid = threadIdx.x, l = item / 96, n0 = (item % 96) * 64;
    for (int i = tid; i < 9 * 1024; i += 512) { const float c = (i < 8 * 1024) ? a->in[1][i] : a->in[3][i - 8 * 1024]; sv[i] = c / (1.f + __expf(-c)); }
    __syncthreads();
    const int kg = tid >> 6, c = tid & 63;
    const float* w = a->in[4] + (size_t)l * D * 6 * D + n0 + c;
    float acc[9];
#pragma unroll
    for (int r = 0; r < 9; ++r) acc[r] = 0.f;
    for (int k0 = kg; k0 < D; k0 += 64) { float wv[8];
#pragma unroll
        for (int q = 0; q < 8; ++q) wv[q] = w[(size_t)(k0 + 8 * q) * 6 * D];
#pragma unroll
        for (int q = 0; q < 8; ++q)
#pragma unroll
            for (int r = 0; r < 9; ++r) acc[r] += sv[r * 1024 + k0 + 8 * q] * wv[q]; }
#pragma unroll
    for (int r = 0; r < 9; ++r) red[(kg * 9 + r) * 64 + c] = acc[r];
    __syncthreads();
    float* mod = (float*)(a->ws + WS_MOD) + (size_t)l * 9 * 6 * D;
    for (int i = tid; i < 9 * 64; i += 512) { const int r = i >> 6, cc = i & 63; float s = a->in[5][(size_t)l * 6 * D + n0 + cc];
#pragma unroll
        for (int q = 0; q < 8; ++q) s += red[(q * 9 + r) * 64 + cc];
        mod[(size_t)r * 6 * D + n0 + cc] = s; }
    __syncthreads();
}

DI void unpack8(const u32x4& w, float* o) { o[0] = bflo(w.x); o[1] = bfhi(w.x); o[2] = bflo(w.y); o[3] = bfhi(w.y); o[4] = bflo(w.z); o[5] = bfhi(w.z); o[6] = bflo(w.w); o[7] = bfhi(w.w); }
DI u32x4 packv8(const float* o) { u32x4 w; w.x = pk2(o[0], o[1]); w.y = pk2(o[2], o[3]); w.z = pk2(o[4], o[5]); w.w = pk2(o[6], o[7]); return w; }
DI void ctx_fixup(float* xc, const float* parts, const float* pgate, int row0, int nrows) {
    int tx_ = threadIdx.x; asm volatile("" : "+v"(tx_));
    const int lane = tx_ & 63, gw = blockIdx.x * 8 + (tx_ >> 6), nw = gridDim.x * 8;
    for (int r = row0 + gw; r < row0 + nrows; r += nw) {
#pragma unroll
        for (int i = 0; i < 4; ++i) { const int c = lane * 4 + 256 * i; f32x4 sm = *(const f32x4*)(parts + (size_t)r * D + c);
#pragma unroll
            for (int ks = 1; ks < 8; ++ks) sm += *(const f32x4*)(parts + (size_t)ks * M_CTX * D + (size_t)r * D + c);
            *(f32x4*)(xc + (size_t)r * D + c) = *(const f32x4*)(xc + (size_t)r * D + c) + *(const f32x4*)(pgate + c) * sm; }
    }
}
DI void norm_phase(const float* src_lat, const float* src_ctx, int nlat, int ntot, int latoff, int ctxoff,
                   const float* __restrict__ gnorm, const float* __restrict__ modl, int shoff, int scoff, bf16_t* dst) {
    int tx_ = threadIdx.x; asm volatile("" : "+v"(tx_));
    const int lane = tx_ & 63, gw = blockIdx.x * 8 + (tx_ >> 6), nw = gridDim.x * 8;
    for (int r = gw; r < ntot; r += nw) {
        const bool lat = r < nlat;
        const float* x = lat ? src_lat + (size_t)(latoff + r) * D : src_ctx + (size_t)(ctxoff + r - nlat) * D;
        const int b = lat ? (latoff + r) / SEQ : NBATCH;
        const float* mb = modl + (size_t)b * 6 * D;
        f32x4 v[4], g[4], sc[4], sh[4]; float ss = 0.f;
#pragma unroll
        for (int i = 0; i < 4; ++i) { const int c = lane * 4 + 256 * i; v[i] = *(const f32x4*)(x + c); g[i] = *(const f32x4*)(gnorm + c); sc[i] = *(const f32x4*)(mb + scoff + c); sh[i] = *(const f32x4*)(mb + shoff + c); }
#pragma unroll
        for (int i = 0; i < 4; ++i) ss += v[i][0] * v[i][0] + v[i][1] * v[i][1] + v[i][2] * v[i][2] + v[i][3] * v[i][3];
        ss = wave_sum(ss);
        const float rstd = rsqrtf(ss * (1.f / D) + EPS);
#pragma unroll
        for (int i = 0; i < 4; ++i) { const int c = lane * 4 + 256 * i;
            f32x4 y;
#pragma unroll
            for (int j = 0; j < 4; ++j) y[j] = (v[i][j] * rstd * g[i][j]) * (1.f + sc[i][j]) + sh[i][j];
            u32x2 w; w.x = pk2(y[0], y[1]); w.y = pk2(y[2], y[3]);
            *(u32x2*)(dst + (size_t)r * D + c) = w; }
    }
}

DI void prep_phase(KArgs a, int l, bool want_ctx, bf16_t* P, const bf16_t* T, bf16_t* Qb, bf16_t* Qc, bf16_t* Kb, bf16_t* Vb, const float* ropetab) {
    int tx_ = threadIdx.x; asm volatile("" : "+v"(tx_));
    const int lane = tx_ & 63, gw = blockIdx.x * 8 + (tx_ >> 6), nw = gridDim.x * 8;
    const int hd = lane >> 3, k = lane & 7;
    const float* gq = a->in[17] + l * 96; const float* gk = a->in[18] + l * 96;
    float gqn[8], gqr[4], gkn[8], gkr[4], nqw[16];
#pragma unroll
    for (int i = 0; i < 8; ++i) { gqn[i] = gq[8 * k + i]; gkn[i] = gk[8 * k + i]; }
#pragma unroll
    for (int i = 0; i < 4; ++i) { gqr[i] = gq[64 + 4 * k + i]; gkr[i] = gk[64 + 4 * k + i]; }
    const float QS = 0.10206207261596577f * LOG2E, NAS = 0.125f * LOG2E;
    { const float* nw_ = (lane < 32) ? a->in[20] + l * 64 : a->in[21] + l * 64; const float sc_ = (lane < 32) ? NAS : 1.f;
#pragma unroll
      for (int i = 0; i < 16; ++i) nqw[i] = nw_[16 * (lane & 3) + i] * sc_; }
    const int sec = k >> 2, second = (k >> 1) & 1;
    for (int r = gw; r < MG; r += nw) {
        const bool lat = r < MG_LAT;
        int bl, tt, tall;
        if (lat) { bl = r / SEQ; tt = r % SEQ; tall = CTXL + tt; } else { const int rc = r - MG_LAT; bl = rc / CTXL; tt = rc % CTXL; tall = tt; }
        const bool need_q = lat || want_ctx;
        bf16_t* Pr = P + (size_t)r * NP; const bf16_t* Tr = T + (size_t)r * TW;
        const u32x4 d0 = *(const u32x4*)(Pr + PC_DQ + 8 * lane);
        u32x4 d1 = (u32x4){0u, 0u, 0u, 0u}; if (lane < 16) d1 = *(const u32x4*)(Pr + PC_DQ + 512 + 8 * lane);
        const u32x2 krw = *(const u32x2*)(Pr + PC_KR + 4 * k);
        const u32x4 tqn = *(const u32x4*)(Tr + hd * 96 + 8 * k); const u32x2 tqr = *(const u32x2*)(Tr + hd * 96 + 64 + 4 * k);
        const u32x4 tkn = *(const u32x4*)(Tr + 768 + hd * 128 + 8 * k), tv = *(const u32x4*)(Tr + 768 + hd * 128 + 64 + 8 * k);
        u32x4 na0 = *(const u32x4*)(Pr + PC_NAQ + 16 * lane), na1 = *(const u32x4*)(Pr + PC_NAQ + 16 * lane + 8);
        f32x4 rt0 = (f32x4){1.f, 0.f, 1.f, 0.f}, rt1 = rt0;
        if (lat) { const int pos = sec ? (tt & 63) : (tt >> 6); const float* rp = ropetab + (size_t)(pos * 8 + 4 * (k & 1)) * 2; rt0 = *(const f32x4*)rp; rt1 = *(const f32x4*)(rp + 4); }
        float e0[8], e1[8]; unpack8(d0, e0); unpack8(d1, e1);
        float s0 = 0.f, s1 = 0.f;
#pragma unroll
        for (int i = 0; i < 8; ++i) { s0 += e0[i] * e0[i]; s1 += e1[i] * e1[i]; }
        const float ssq = wave_sum(lane < 48 ? s0 : 0.f), skv = wave_sum((lane < 48 ? 0.f : s0) + s1);
        const float rstd_q = rsqrtf(ssq * (1.f / 384.f) + EPS), rstd_kv = rsqrtf(skv * (1.f / 256.f) + EPS);
        const float cs4[4] = {rt0[0], rt0[2], rt1[0], rt1[2]}, sn4[4] = {rt0[1], rt0[3], rt1[1], rt1[3]};
        if (need_q) {
            float xn[8], xr[4]; unpack8(tqn, xn); xr[0] = bflo(tqr.x); xr[1] = bfhi(tqr.x); xr[2] = bflo(tqr.y); xr[3] = bfhi(tqr.y);
            float ss = 0.f;
#pragma unroll
            for (int i = 0; i < 8; ++i) { xn[i] *= rstd_q; ss += xn[i] * xn[i]; }
#pragma unroll
            for (int i = 0; i < 4; ++i) { xr[i] *= rstd_q; ss += xr[i] * xr[i]; }
            const float rs = rsqrtf(sum8(ss) * (1.f / 96.f) + EPS) ;
#pragma unroll
            for (int i = 0; i < 8; ++i) xn[i] = xn[i] * rs * gqn[i] * QS;
#pragma unroll
            for (int i = 0; i < 4; ++i) { const float y = xr[i] * rs * gqr[i]; const float xp = dpp_f<0x4E>(y); xr[i] = (second ? y * cs4[i] + xp * sn4[i] : y * cs4[i] - xp * sn4[i]) * QS; }
            bf16_t* dst = lat ? Qb + ((size_t)(bl * 8 + hd) * SEQ + tt) * 96 : Qc + ((size_t)(bl * 8 + hd) * CTXL + tt) * 96;
            *(u32x4*)(dst + 8 * k) = packv8(xn); u32x2 w; w.x = pk2(xr[0], xr[1]); w.y = pk2(xr[2], xr[3]); *(u32x2*)(dst + 64 + 4 * k) = w;
        }
        {
            float xn[8], xr[4], vv[8]; unpack8(tkn, xn); unpack8(tv, vv); xr[0] = bflo(krw.x); xr[1] = bfhi(krw.x); xr[2] = bflo(krw.y); xr[3] = bfhi(krw.y);
            float ss = 0.f;
#pragma unroll
            for (int i = 0; i < 8; ++i) { xn[i] *= rstd_kv; vv[i] *= rstd_kv; ss += xn[i] * xn[i]; }
#pragma unroll
            for (int i = 0; i < 4; ++i) ss += xr[i] * xr[i];
            const float rs = rsqrtf(sum8(ss) * (1.f / 96.f) + EPS);
#pragma unroll
            for (int i = 0; i < 8; ++i) xn[i] = xn[i] * rs * gkn[i];
#pragma unroll
            for (int i = 0; i < 4; ++i) { const float y = xr[i] * rs * gkr[i]; const float xp = dpp_f<0x4E>(y); xr[i] = second ? y * cs4[i] + xp * sn4[i] : y * cs4[i] - xp * sn4[i]; }
            bf16_t* dst = Kb + ((size_t)(bl * 8 + hd) * TALL + tall) * 96;
            *(u32x4*)(dst + 8 * k) = packv8(xn); u32x2 w; w.x = pk2(xr[0], xr[1]); w.y = pk2(xr[2], xr[3]); *(u32x2*)(dst + 64 + 4 * k) = w;
            *(u32x4*)(Vb + ((size_t)(bl * 8 + hd) * TALL + tall) * 64 + 8 * k) = packv8(vv);
        }
        {
            float x0[8], x1[8]; unpack8(na0, x0); unpack8(na1, x1);
            float ss = 0.f;
#pragma unroll
            for (int i = 0; i < 8; ++i) ss += x0[i] * x0[i] + x1[i] * x1[i];
            const float rs = rsqrtf(sum4(ss) * (1.f / 64.f) + EPS);
#pragma unroll
            for (int i = 0; i < 8; ++i) { x0[i] = x0[i] * rs * nqw[i]; x1[i] = x1[i] * rs * nqw[8 + i]; }
            *(u32x4*)(Pr + PC_NAQ + 16 * lane) = packv8(x0); *(u32x4*)(Pr + PC_NAQ + 16 * lane + 8) = packv8(x1);
        }
    }
}

DI void mlcomb_phase(KArgs a, int l, int nrows, bf16_t* P, const bf16_t* HD0, const bf16_t* HD1) {
    int tx_ = threadIdx.x; asm volatile("" : "+v"(tx_));
    const int lane = tx_ & 63, gw = blockIdx.x * 8 + (tx_ >> 6), nw = gridDim.x * 8;
    const float* gout = a->in[11] + l * 512 + 8 * lane;
    float go[8];
#pragma unroll
    for (int i = 0; i < 8; ++i) go[i] = gout[i];
    for (int r = gw; r < nrows; r += nw) {
        bf16_t* Pr = P + (size_t)r * NP + PC_MLO + 8 * lane;
        const u32x4 w0 = *(const u32x4*)(HD0 + (size_t)r * 512 + 8 * lane), w1 = *(const u32x4*)(HD1 + (size_t)r * 512 + 8 * lane), wo = *(const u32x4*)Pr;
        float h0[8], h1[8], o[8]; unpack8(w0, h0); unpack8(w1, h1); unpack8(wo, o);
        float ss = 0.f;
#pragma unroll
        for (int i = 0; i < 8; ++i) { h0[i] += h1[i]; ss += h0[i] * h0[i]; }
        const float rs = rsqrtf(sum16(ss) * (1.f / 128.f) + EPS);
#pragma unroll
        for (int i = 0; i < 8; ++i) h0[i] = h0[i] * rs * go[i] * sigmoidf_(o[i]);
        *(u32x4*)Pr = packv8(h0);
    }
}

DI float max3f(float a, float b, float c) { float r; asm("v_max3_f32 %0, %1, %2, %3" : "=v"(r) : "v"(a), "v"(b), "v"(c)); return r; }
DI float max2f(float a, float b) { float r; asm("v_max_f32_e32 %0, %1, %2" : "=v"(r) : "v"(a), "v"(b)); return r; }
typedef short s16x4 __attribute__((ext_vector_type(4)));
DI s16x4 vtr(const LAS char* p) { return __builtin_bit_cast(s16x4, __builtin_amdgcn_ds_read_tr16_b64_v4i16((LAS s16x4*)p)); }
DI int crow(int reg, int h) { return (reg & 3) + 8 * (reg >> 2) + 4 * h; }
#define MFMA32(a, b, c) __builtin_amdgcn_mfma_f32_32x32x16_bf16((a), (b), (c), 0, 0, 0)
DI bf16x8 pack8(const f32x16& x, int s) {
    u32x4 p; p.x = pk2(x[8 * s], x[8 * s + 1]); p.y = pk2(x[8 * s + 2], x[8 * s + 3]); p.z = pk2(x[8 * s + 4], x[8 * s + 5]); p.w = pk2(x[8 * s + 6], x[8 * s + 7]);
    return __builtin_bit_cast(bf16x8, p);
}
struct AttnP {
    const bf16_t* Q; int q_ld;
    const bf16_t* Kb; const bf16_t* Vb;
    const bf16_t* Kc; const bf16_t* Vc;
    bf16_t* O; int o_ld;
    int ntiles, nb, rlo, r0;
    const float* rpb;
    int fix;
    float C;
};
template <int MODE, bool FIX>
DI void attn_unit(char* lds, const AttnP& p) {
    constexpr int DQK = MODE == 0 ? 96 : 64, NST = DQK / 16, NCH = DQK / 8, KSTRB = (DQK + 8) * 2, VSTRB = 144, KBUF = 13312, VBUF = 9216;
    char* Kb0 = lds; char* Vb0 = lds + 2 * KBUF; float* rpbL = (float*)(lds + 2 * KBUF + 2 * VBUF);
    int tid = threadIdx.x; asm volatile("" : "+v"(tid));
    const int w = tid >> 6, lane = tid & 63, r = lane & 31, h = lane >> 5;
    const int nt = p.ntiles;
    bf16x8 qf[NST];
    { const bf16_t* qp = p.Q + (size_t)(32 * w + r) * p.q_ld + 8 * h;
#pragma unroll
      for (int st = 0; st < NST; ++st) qf[st] = *(const bf16x8*)(qp + 16 * st); }
    f32x16 o0, o1, p0, p1, n0, n1;
#pragma unroll
    for (int i = 0; i < 16; ++i) { o0[i] = 0.f; o1[i] = 0.f; p0[i] = 0.f; p1[i] = 0.f; n0[i] = 0.f; n1[i] = 0.f; }
    float m_run = -1e30f, l_run = 0.f;
    const float sinit = FIX ? -p.C : 0.f;
    const int rq = p.r0 + (w >> 1), rs = min(max(rq - 4, 0), 56), qc = 32 * (w & 1) + r, cs = min(max(qc - 8, 0), 48);
    unsigned idxp0[4], idxp1[4];
    if (MODE == 1) {
        for (int i = tid; i < 480; i += 512) { const int dr = i >> 5, d = i & 31; rpbL[i] = (d < 31) ? p.rpb[dr * 31 + d] * LOG2E : -1e30f; }
#pragma unroll
        for (int k4 = 0; k4 < 4; ++k4) { unsigned a0 = 0u, a1 = 0u;
#pragma unroll
            for (int m = 0; m < 4; ++m) { const int i = 4 * k4 + m; const int c0 = crow(i, h), c1 = 32 + c0;
                a0 |= (unsigned)((((unsigned)(c0 - cs) < 16u) ? (c0 - qc + 15) : 31) * 4) << (8 * m);
                a1 |= (unsigned)((((unsigned)(c1 - cs) < 16u) ? (c1 - qc + 15) : 31) * 4) << (8 * m); }
            idxp0[k4] = a0; idxp1[k4] = a1; }
    }
    const int krow0 = tid / NCH, kch0 = tid % NCH, krow1 = (tid + 512) / NCH, kch1 = (tid + 512) % NCH;
    const bool k2 = (MODE == 0) && (tid < 256);
    const int vkey = tid >> 3, vdg = tid & 7;
    u32x4 kr0, kr1 = (u32x4){0u, 0u, 0u, 0u}, vr, kx0 = (u32x4){0u, 0u, 0u, 0u}, kx1 = (u32x4){0u, 0u, 0u, 0u}, vx = (u32x4){0u, 0u, 0u, 0u};
#define ATT_KV(j) const bf16_t* kp; const bf16_t* vp; size_t kld, vld; \
        if (MODE == 0) { kp = p.Kb + (size_t)(j) * 64 * 96; vp = p.Vb + (size_t)(j) * 64 * 64; kld = 96; vld = 64; } \
        else if ((j) < p.nb) { kp = p.Kb + (size_t)(p.rlo + (j)) * 64 * NP; vp = p.Vb + (size_t)(p.rlo + (j)) * 64 * NP; kld = NP; vld = NP; } \
        else { kp = p.Kc + (size_t)((j) - p.nb) * 64 * NP; vp = p.Vc + (size_t)((j) - p.nb) * 64 * NP; kld = NP; vld = NP; }
#define ATT_LOADK(j) do { ATT_KV(j); (void)vp; (void)vld; kr0 = *(const u32x4*)(kp + (size_t)krow0 * kld + kch0 * 8); if (k2) kr1 = *(const u32x4*)(kp + (size_t)krow1 * kld + kch1 * 8); } while (0)
#define ATT_LOADV(j) do { ATT_KV(j); (void)kp; (void)kld; vr = *(const u32x4*)(vp + (size_t)vkey * vld + vdg * 8); } while (0)
#define ATT_LOADKX(j) do { ATT_KV(j); (void)vp; (void)vld; kx0 = *(const u32x4*)(kp + (size_t)krow0 * kld + kch0 * 8); if (k2) kx1 = *(const u32x4*)(kp + (size_t)krow1 * kld + kch1 * 8); } while (0)
#define ATT_LOADVX(j) do { ATT_KV(j); (void)kp; (void)kld; vx = *(const u32x4*)(vp + (size_t)vkey * vld + vdg * 8); } while (0)
#define ATT_STOREK(b) do { char* Ks_ = Kb0 + (b) * KBUF; *(u32x4*)(Ks_ + krow0 * KSTRB + kch0 * 16) = kr0; if (k2) *(u32x4*)(Ks_ + krow1 * KSTRB + kch1 * 16) = kr1; } while (0)
#define ATT_STOREV(b) do { *(u32x4*)(Vb0 + (b) * VBUF + vkey * VSTRB + vdg * 16) = vr; } while (0)
#define ATT_QK(S0, S1, b) do { const char* Ks_ = Kb0 + (b) * KBUF + r * KSTRB + 16 * h; \
        _Pragma("unroll") for (int i_ = 0; i_ < 16; ++i_) { S0[i_] = sinit; S1[i_] = sinit; } \
        _Pragma("unroll") for (int st = 0; st < NST; ++st) { const bf16x8 a0 = *(const bf16x8*)(Ks_ + 32 * st), a1 = *(const bf16x8*)(Ks_ + 32 * KSTRB + 32 * st); \
            S0 = MFMA32(a0, qf[st], S0); S1 = MFMA32(a1, qf[st], S1); } } while (0)
#define ATT_ACT(j) (!((MODE == 1) && ((j) < p.nb) && !((p.rlo + (j)) >= rs && (p.rlo + (j)) < rs + 8)))
    ATT_LOADK(0); ATT_LOADV(0); ATT_STOREK(0); ATT_STOREV(0);
    if (nt > 1) { ATT_LOADK(1); ATT_STOREK(1); }
    if (nt > 2) ATT_LOADK(2);
    if (nt > 1) ATT_LOADV(1);
    __syncthreads();
    if (ATT_ACT(0)) ATT_QK(p0, p1, 0);
    __syncthreads();
    int j = 0;
#pragma unroll
    for (int ph = 0; ph < 2; ++ph) {
    const bool FULL = (ph == 0);
    const int jend = FULL ? nt - 3 : nt;
    for (; j < jend; ++j) {
        if (FULL || j + 2 < nt) ATT_STOREK(j & 1);
        if (FULL || j + 1 < nt) ATT_STOREV((j + 1) & 1);
        if (FULL || j + 3 < nt) ATT_LOADK(j + 3);
        if (FULL || j + 2 < nt) ATT_LOADV(j + 2);
        if (MODE == 0) { ATT_QK(n0, n1, (j + 1) & 1); }
        else if (j + 1 < nt && ATT_ACT(j + 1)) { ATT_QK(n0, n1, (j + 1) & 1); }
        if (ATT_ACT(j)) {
            if ((MODE == 1) && (j < p.nb)) {
                const char* browb = (const char*)(rpbL + (p.rlo + j - rq + 7) * 32);
#pragma unroll
                for (int i = 0; i < 16; ++i) { p0[i] += *(const float*)(browb + ((idxp0[i >> 2] >> (8 * (i & 3))) & 0xffu)); p1[i] += *(const float*)(browb + ((idxp1[i >> 2] >> (8 * (i & 3))) & 0xffu)); }
            }
            if (FIX) {
#pragma unroll
                for (int i = 0; i < 16; ++i) { p0[i] = __builtin_amdgcn_exp2f(p0[i]); p1[i] = __builtin_amdgcn_exp2f(p1[i]); }
                const f32x16 ps = p0 + p1;
                l_run += ((ps[0] + ps[1]) + (ps[2] + ps[3])) + ((ps[4] + ps[5]) + (ps[6] + ps[7])) + ((ps[8] + ps[9]) + (ps[10] + ps[11])) + ((ps[12] + ps[13]) + (ps[14] + ps[15]));
            } else {
            float tmax = max2f(p0[0], p1[0]), tmax2 = max2f(p0[1], p1[1]);
#pragma unroll
            for (int i = 2; i < 16; i += 2) { tmax = max3f(tmax, p0[i], p1[i]); tmax2 = max3f(tmax2, p0[i + 1], p1[i + 1]); }
            tmax = max2f(tmax, tmax2);
            tmax = max2f(tmax, shx(tmax, lane, 32));
            const float m_new = max2f(m_run, tmax), alpha = __builtin_amdgcn_exp2f(m_run - m_new);
            p0 = p0 - m_new; p1 = p1 - m_new;
#pragma unroll
            for (int i = 0; i < 16; ++i) { p0[i] = __builtin_amdgcn_exp2f(p0[i]); p1[i] = __builtin_amdgcn_exp2f(p1[i]); }
            const f32x16 ps = p0 + p1;
            float rsum = ((ps[0] + ps[1]) + (ps[2] + ps[3])) + ((ps[4] + ps[5]) + (ps[6] + ps[7])) + ((ps[8] + ps[9]) + (ps[10] + ps[11])) + ((ps[12] + ps[13]) + (ps[14] + ps[15]));
            rsum += shx(rsum, lane, 32);
            l_run = l_run * alpha + rsum; m_run = m_new;
            o0 = o0 * alpha; o1 = o1 * alpha;
            }
            const LAS char* vbase = (const LAS char*)(Vb0 + (j & 1) * VBUF) + (4 * h + ((lane & 15) >> 2)) * VSTRB + ((lane >> 4) & 1) * 32 + (lane & 3) * 8;
#pragma unroll
            for (int kb = 0; kb < 2; ++kb)
#pragma unroll
                for (int s = 0; s < 2; ++s) {
                    const bf16x8 pf = pack8(kb ? p1 : p0, s);
                    const LAS char* vb = vbase + (32 * kb + 16 * s) * VSTRB;
                    const s16x4 l0 = vtr(vb), h0 = vtr(vb + 8 * VSTRB), l1 = vtr(vb + 64), h1 = vtr(vb + 8 * VSTRB + 64);
                    const bf16x8 v0 = __builtin_shufflevector(l0, h0, 0, 1, 2, 3, 4, 5, 6, 7), v1 = __builtin_shufflevector(l1, h1, 0, 1, 2, 3, 4, 5, 6, 7);
                    o0 = MFMA32(v0, pf, o0); o1 = MFMA32(v1, pf, o1);
                }
        }
        __syncthreads();
        p0 = n0; p1 = n1;
    }
    }
#undef ATT_KV
#undef ATT_LOADK
#undef ATT_LOADV
#undef ATT_LOADKX
#undef ATT_LOADVX
#undef ATT_STOREK
#undef ATT_STOREV
#undef ATT_QK
#undef ATT_ACT
    if (FIX) l_run += shx(l_run, lane, 32);
    const float inv = 1.f / l_run;
    bf16_t* op = p.O + (size_t)(32 * w + r) * p.o_ld + 4 * h;
#pragma unroll
    for (int i4 = 0; i4 < 4; ++i4) {
        u32x2 w0, w1; w0.x = pk2(o0[4 * i4] * inv, o0[4 * i4 + 1] * inv); w0.y = pk2(o0[4 * i4 + 2] * inv, o0[4 * i4 + 3] * inv);
        w1.x = pk2(o1[4 * i4] * inv, o1[4 * i4 + 1] * inv); w1.y = pk2(o1[4 * i4 + 2] * inv, o1[4 * i4 + 3] * inv);
        *(u32x2*)(op + 8 * i4) = w0; *(u32x2*)(op + 32 + 8 * i4) = w1;
    }
}

#define ML_ROW(ci, t) (((ci) < 4) ? (MG_LAT + bl * CTXL + (dir ? (3 - (ci)) * 64 + 63 - (t) : (ci) * 64 + (t))) : (bl * SEQ + (dir ? (67 - (ci)) * 64 + 63 - (t) : ((ci) - 4) * 64 + (t))))
constexpr int ML_NSEQ = 32, ML_NCH = 68, ML_ITEMS = ML_NSEQ * ML_NCH;
constexpr size_t WS_DC = WS_H, WS_CS = 475 * MiB, WS_SM = 509 * MiB, SM_DN = 0, SM_NST = 0x90000, SM_SCAL = 0x120000, SM_MST = 0x128000, SM_TAB = 0x130000;
DI void mlA_phase(char* lds, KArgs a, int l, const bf16_t* P, unsigned char* ws) {
    constexpr int STR = 144;
    char* KTs = lds + 18432; char* VTs = lds + 27648;
    float* tab = (float*)(lds + 64512); float* tu = tab; float* misc = tab + 384;
    int tid = threadIdx.x; asm volatile("" : "+v"(tid));
    const int w = tid >> 6, lane = tid & 63, r = lane & 31, h = lane >> 5, eb = w >> 1, xb = w & 1;
    const int srow = tid >> 3, sch = tid & 7;
    const int G = gridDim.x;
    u32x4 rk, rv0, rv1; float gi = 0.f, gf = 0.f;
#define MLA_LOAD(item) do { const int sq_ = (item) / ML_NCH, ci_ = (item) % ML_NCH, dir = sq_ & 1, hh_ = (sq_ >> 1) & 3, bl = sq_ >> 3; \
        const bf16_t* pr = P + (size_t)ML_ROW(ci_, srow) * NP; \
        rk = *(const u32x4*)(pr + PC_MLK + hh_ * 64 + sch * 8); rv0 = *(const u32x4*)(pr + PC_MLV + hh_ * 128 + sch * 8); rv1 = *(const u32x4*)(pr + PC_MLV + hh_ * 128 + 64 + sch * 8); \
        if (w == 0) { const bf16_t* pg = P + (size_t)ML_ROW(ci_, lane) * NP + PC_GT; gi = bf2f(pg[(2 * dir) * 4 + hh_]); gf = bf2f(pg[(2 * dir + 1) * 4 + hh_]); } } while (0)
    int item = blockIdx.x;
    if (item < ML_ITEMS) MLA_LOAD(item);
    for (; item < ML_ITEMS; item += G) {
        const int sq = item / ML_NCH, dir = sq & 1, hh = (sq >> 1) & 3;
        if (w == 0) {
            const float ib = a->in[9][(l * 2 + dir) * 4 + hh], fb = a->in[10][(l * 2 + dir) * 4 + hh];
            const float x = gf + fb;
            const float lf = fminf(x, 0.f) - log1pf(expf(-fabsf(x)));
            float bc = lf;
#pragma unroll
            for (int o = 1; o < 64; o <<= 1) { const float v = shu(bc, lane, o); if (lane >= o) bc += v; }
            const float u = gi + ib - bc;
            float am = u;
#pragma unroll
            for (int o = 1; o < 64; o <<= 1) { const float v = shu(am, lane, o); if (lane >= o) am = fmaxf(am, v); }
            { float* tb = (float*)(ws + WS_SM + SM_TAB) + (size_t)item * 192; tb[lane] = u; tb[64 + lane] = bc; tb[128 + lane] = am; }
            tu[lane] = u;
            const float btot = rdl63(bc); am = rdl63(am);
            if (lane == 0) { misc[1] = am; float* sc = (float*)(ws + WS_SM + SM_SCAL) + (size_t)item * 2; sc[0] = btot; sc[1] = am; }
        }
        { const unsigned vw[8] = {rv0.x, rv0.y, rv0.z, rv0.w, rv1.x, rv1.y, rv1.z, rv1.w};
#pragma unroll
          for (int i = 0; i < 8; ++i) { const int e = (i < 4 ? 0 : 64) + sch * 8 + 2 * (i & 3);
              *(bf16_t*)(VTs + e * STR + srow * 2) = (bf16_t)(vw[i] & 0xffffu); *(bf16_t*)(VTs + (e + 1) * STR + srow * 2) = (bf16_t)(vw[i] >> 16); } }
        __syncthreads();
        { const float wk = __expf(tu[srow] - misc[1]);
          const unsigned kw[4] = {rk.x, rk.y, rk.z, rk.w};
#pragma unroll
          for (int i = 0; i < 4; ++i) { *(bf16_t*)(KTs + (sch * 8 + 2 * i) * STR + srow * 2) = f2bf(bflo(kw[i]) * wk); *(bf16_t*)(KTs + (sch * 8 + 2 * i + 1) * STR + srow * 2) = f2bf(bfhi(kw[i]) * wk); } }
        if (item + G < ML_ITEMS) MLA_LOAD(item + G);
        __syncthreads();
        {
            f32x16 C;
#pragma unroll
            for (int i = 0; i < 16; ++i) C[i] = 0.f;
#pragma unroll
            for (int st = 0; st < 4; ++st) {
                const bf16x8 vA = *(const bf16x8*)(VTs + (32 * eb + r) * STR + (16 * st + 8 * h) * 2), kB = *(const bf16x8*)(KTs + (32 * xb + r) * STR + (16 * st + 8 * h) * 2);
                C = MFMA32(vA, kB, C);
            }
            bf16_t* dc = (bf16_t*)(ws + WS_DC) + (size_t)item * 8192;
#pragma unroll
            for (int i = 0; i < 16; ++i) dc[(32 * eb + crow(i, h)) * 64 + 32 * xb + r] = f2bf(C[i]);
            const u32x4 kk = *(const u32x4*)(KTs + srow * STR + sch * 16);
            float sm = bflo(kk.x) + bfhi(kk.x) + bflo(kk.y) + bfhi(kk.y) + bflo(kk.z) + bfhi(kk.z) + bflo(kk.w) + bfhi(kk.w);
            sm += shx(sm, lane, 1); sm += shx(sm, lane, 2); sm += shx(sm, lane, 4);
            if (sch == 0) ((float*)(ws + WS_SM + SM_DN))[(size_t)item * 64 + srow] = sm;
        }
        __syncthreads();
    }
#undef MLA_LOAD
}
DI void mlB_phase(char* lds, unsigned char* ws) {
    int tx_ = threadIdx.x; asm volatile("" : "+v"(tx_));
    const int gt = blockIdx.x * 512 + tx_;
    const int sq = (blockIdx.x * 512) >> 12, pi = gt & 4095;
    float* sA = (float*)lds; float* sB = sA + 80; float* sM = sA + 160; float* sBt = sA + 240; float* sMl = sA + 320;
    if (sq >= ML_NSEQ) return;
    if (tx_ < ML_NCH) { const float* sc = (const float*)(ws + WS_SM + SM_SCAL) + ((size_t)sq * ML_NCH + tx_) * 2; sBt[tx_] = sc[0]; sMl[tx_] = sc[1]; }
    __syncthreads();
    if (tx_ == 0) { float m = 0.f;
        for (int ci = 0; ci < ML_NCH; ++ci) { const float M = fmaxf(m, sMl[ci]); sA[ci] = __expf(m - M); sB[ci] = __expf(sMl[ci] - M); sM[ci] = m; m = sBt[ci] + M; } }
    __syncthreads();
    const unsigned* __restrict__ dc = (const unsigned*)(ws + WS_DC) + (size_t)sq * ML_NCH * 4096 + pi;
    unsigned* __restrict__ cs = (unsigned*)(ws + WS_CS) + (size_t)sq * ML_NCH * 4096 + pi;
    const float* __restrict__ dn = (const float*)(ws + WS_SM + SM_DN) + (size_t)sq * ML_NCH * 64 + pi;
    float* __restrict__ nst = (float*)(ws + WS_SM + SM_NST) + (size_t)sq * ML_NCH * 64 + pi;
    float* __restrict__ mst = (float*)(ws + WS_SM + SM_MST) + (size_t)sq * ML_NCH;
    float c0 = 0.f, c1 = 0.f, n = 0.f;
    for (int cb = 0; cb < ML_NCH; cb += 17) {
        unsigned dv[17]; float dnv[17];
#pragma unroll
        for (int q = 0; q < 17; ++q) { dv[q] = dc[(size_t)(cb + q) * 4096]; dnv[q] = (pi < 64) ? dn[(size_t)(cb + q) * 64] : 0.f; }
#pragma unroll
        for (int q = 0; q < 17; ++q) {
            const int ci = cb + q;
            cs[(size_t)ci * 4096] = pk2(c0, c1);
            if (pi < 64) nst[(size_t)ci * 64] = n;
            if (pi == 0) mst[ci] = sM[ci];
            const float aa = sA[ci], bb = sB[ci];
            c0 = aa * c0 + bb * bflo(dv[q]); c1 = aa * c1 + bb * bfhi(dv[q]); n = aa * n + bb * dnv[q];
        }
    }
    __syncthreads();
}
DI void mlC_phase(char* lds, const bf16_t* P, unsigned char* ws, bf16_t* HD0, bf16_t* HD1) {
    constexpr int STR = 144;
    char* Qs = lds; char* Ks = lds + 9216; char* VTs = lds + 27648; char* CTs = lds + 46080;
    float* tab = (float*)(lds + 64512); float* tu = tab; float* tM = tab + 64; float* tbc = tab + 128; float* tain = tab + 192; float* qn = tab + 320;
    int tid = threadIdx.x; asm volatile("" : "+v"(tid));
    const int w = tid >> 6, lane = tid & 63, r = lane & 31, h = lane >> 5, eb = w >> 1, xb = w & 1;
    const int srow = tid >> 3, sch = tid & 7, G = gridDim.x;
    u32x4 rq, rk, rv0, rv1, cs0, cs1; f32x4 n0, n1; float m_state = 0.f, gu = 0.f, gbc = 0.f, gam = 0.f;
#define MLC_LOAD(item) do { const int sq_ = (item) / ML_NCH, ci_ = (item) % ML_NCH, dir = sq_ & 1, hh_ = (sq_ >> 1) & 3, bl = sq_ >> 3; \
        const bf16_t* pr = P + (size_t)ML_ROW(ci_, srow) * NP; \
        rq = *(const u32x4*)(pr + PC_MLQ + hh_ * 64 + sch * 8); rk = *(const u32x4*)(pr + PC_MLK + hh_ * 64 + sch * 8); \
        rv0 = *(const u32x4*)(pr + PC_MLV + hh_ * 128 + sch * 8); rv1 = *(const u32x4*)(pr + PC_MLV + hh_ * 128 + 64 + sch * 8); \
        const u32x4* csp = (const u32x4*)((const bf16_t*)(ws + WS_CS) + (size_t)(item) * 8192); cs0 = csp[tid]; cs1 = csp[tid + 512]; \
        const float* nstp = (const float*)(ws + WS_SM + SM_NST) + (size_t)(item) * 64 + sch * 8; n0 = *(const f32x4*)nstp; n1 = *(const f32x4*)(nstp + 4); \
        m_state = ((const float*)(ws + WS_SM + SM_MST))[item]; \
        if (w == 0) { const float* tb = (const float*)(ws + WS_SM + SM_TAB) + (size_t)(item) * 192; gu = tb[lane]; gbc = tb[64 + lane]; gam = tb[128 + lane]; } } while (0)
    int item = blockIdx.x;
    if (item < ML_ITEMS) MLC_LOAD(item);
    for (; item < ML_ITEMS; item += G) {
        const int sq = item / ML_NCH, ci = item % ML_NCH, dir = sq & 1, hh = (sq >> 1) & 3, bl = sq >> 3;
        bf16_t* HD = dir ? HD1 : HD0;
        if (w == 0) { const float Mt = fmaxf(m_state, gam); tu[lane] = gu; tM[lane] = Mt; tbc[lane] = gbc; tain[lane] = __expf(m_state - Mt); }
        float qv[8];
        { const unsigned qw[4] = {rq.x, rq.y, rq.z, rq.w};
#pragma unroll
          for (int i = 0; i < 4; ++i) { qv[2 * i] = bflo(qw[i]) * 0.125f; qv[2 * i + 1] = bfhi(qw[i]) * 0.125f; } }
        { u32x4 qs; qs.x = pk2(qv[0], qv[1]); qs.y = pk2(qv[2], qv[3]); qs.z = pk2(qv[4], qv[5]); qs.w = pk2(qv[6], qv[7]);
          *(u32x4*)(Qs + srow * STR + sch * 16) = qs; *(u32x4*)(Ks + srow * STR + sch * 16) = rk; }
        { const unsigned vw[8] = {rv0.x, rv0.y, rv0.z, rv0.w, rv1.x, rv1.y, rv1.z, rv1.w};
#pragma unroll
          for (int i = 0; i < 8; ++i) { const int e = (i < 4 ? 0 : 64) + sch * 8 + 2 * (i & 3);
              *(bf16_t*)(VTs + e * STR + srow * 2) = (bf16_t)(vw[i] & 0xffffu); *(bf16_t*)(VTs + (e + 1) * STR + srow * 2) = (bf16_t)(vw[i] >> 16); } }
        *(u32x4*)(CTs + (tid >> 3) * STR + (tid & 7) * 16) = cs0; *(u32x4*)(CTs + (64 + (tid >> 3)) * STR + (tid & 7) * 16) = cs1;
        { float sm = qv[0] * n0[0] + qv[1] * n0[1] + qv[2] * n0[2] + qv[3] * n0[3] + qv[4] * n1[0] + qv[5] * n1[1] + qv[6] * n1[2] + qv[7] * n1[3];
          sm += shx(sm, lane, 1); sm += shx(sm, lane, 2); sm += shx(sm, lane, 4);
          if (sch == 0) qn[srow] = sm; }
        if (item + G < ML_ITEMS) MLC_LOAD(item + G);
        __syncthreads();
        {
            const int t = 32 * xb + r;
            f32x16 X0, X1, Y;
#pragma unroll
            for (int i = 0; i < 16; ++i) { X0[i] = 0.f; X1[i] = 0.f; Y[i] = 0.f; }
#pragma unroll
            for (int st = 0; st < 4; ++st) {
                const bf16x8 qB = *(const bf16x8*)(Qs + t * STR + (16 * st + 8 * h) * 2);
                const bf16x8 k0 = *(const bf16x8*)(Ks + r * STR + (16 * st + 8 * h) * 2), k1 = *(const bf16x8*)(Ks + (32 + r) * STR + (16 * st + 8 * h) * 2);
                const bf16x8 cA = *(const bf16x8*)(CTs + (32 * eb + r) * STR + (16 * st + 8 * h) * 2);
                X0 = MFMA32(k0, qB, X0); X1 = MFMA32(k1, qB, X1); Y = MFMA32(cA, qB, Y);
            }
            const float Mtt = tM[t], ai = tain[t];
            float dsum = 0.f;
#pragma unroll
            for (int i = 0; i < 16; ++i) {
                const int s0 = crow(i, h), s1 = 32 + s0;
                X0[i] = (s0 <= t) ? X0[i] * __expf(tu[s0] - Mtt) : 0.f;
                X1[i] = (s1 <= t) ? X1[i] * __expf(tu[s1] - Mtt) : 0.f;
                dsum += X0[i] + X1[i]; Y[i] *= ai;
            }
            dsum += shx(dsum, lane, 32);
#pragma unroll
            for (int sb = 0; sb < 2; ++sb)
#pragma unroll
                for (int s2 = 0; s2 < 2; ++s2) {
                    const bf16x8 pf = pack8(sb ? X1 : X0, s2);
                    const char* vb = VTs + (32 * eb + r) * STR + (32 * sb + 16 * s2 + 4 * h) * 2;
                    const u32x2 lo = *(const u32x2*)vb, hi = *(const u32x2*)(vb + 16);
                    Y = MFMA32(__builtin_bit_cast(bf16x8, (u32x4){lo.x, lo.y, hi.x, hi.y}), pf, Y);
                }
            const float den = ai * qn[t] + dsum;
            const float inv = 1.f / fmaxf(fabsf(den), __expf(-(tbc[t] + Mtt)));
            bf16_t* op = HD + (size_t)ML_ROW(ci, t) * 512 + hh * 128 + 32 * eb + 4 * h;
#pragma unroll
            for (int i4 = 0; i4 < 4; ++i4) { u32x2 wv; wv.x = pk2(Y[4 * i4] * inv, Y[4 * i4 + 1] * inv); wv.y = pk2(Y[4 * i4 + 2] * inv, Y[4 * i4 + 3] * inv); *(u32x2*)(op + 8 * i4) = wv; }
        }
        __syncthreads();
    }
#undef MLC_LOAD
}

DI int mx_take(volatile int* s_item, unsigned* ctr) {
    if (threadIdx.x == 0) *s_item = (int)atomicAdd(ctr, 1u);
    __syncthreads();
    const int it = *s_item;
    __syncthreads();
    return it;
}
DI void mixer_phase(char* lds, KArgs a, int l, bool want_ctx, unsigned* ctr, unsigned char* ws, bf16_t* P, const bf16_t* Qb, const bf16_t* Qc, const bf16_t* Kb, const bf16_t* Vb, bf16_t* HD0, bf16_t* HD1) {
    volatile int* s_item = (volatile int*)(lds + 140000);
    const int x = (int)(xb_xcc_id() & 7u);
    { float Cmla, Cna; bool fix; int tx_ = threadIdx.x; asm volatile("" : "+v"(tx_)); const int lane = tx_ & 63;
      float gq = 0.f, gk = 0.f, nq = 0.f, nk = 0.f, rb = 0.f;
      for (int i = lane; i < 96; i += 64) { gq = fmaxf(gq, fabsf(a->in[17][l * 96 + i])); gk = fmaxf(gk, fabsf(a->in[18][l * 96 + i])); }
      nq = fabsf(a->in[20][l * 64 + lane]); nk = fabsf(a->in[21][l * 64 + lane]);
      for (int i = lane; i < 8 * 465; i += 64) rb = fmaxf(rb, fabsf(a->in[22][(size_t)l * 8 * 465 + i]));
#pragma unroll
      for (int o = 32; o >= 1; o >>= 1) { gq = fmaxf(gq, shx(gq, lane, o)); gk = fmaxf(gk, shx(gk, lane, o)); nq = fmaxf(nq, shx(nq, lane, o)); nk = fmaxf(nk, shx(nk, lane, o)); rb = fmaxf(rb, shx(rb, lane, o)); }
      Cmla = 9.79796f * gq * gk * LOG2E * 1.02f + 0.05f;
      Cna = (8.f * nq * nk * 1.02f + rb) * LOG2E + 0.05f;
      fix = (Cmla < 40.f) && (Cna < 40.f) && (Cmla == Cmla) && (Cna == Cna);
      volatile float* sc_ = (volatile float*)(lds + 140048);
      if (threadIdx.x == 0) { sc_[0] = Cmla; sc_[1] = Cna; sc_[2] = fix ? 1.f : 0.f; }
      __syncthreads(); }
#define MX_CMLA (((volatile float*)(lds + 140048))[0])
#define MX_CNA (((volatile float*)(lds + 140048))[1])
#define MX_FIX ((((volatile float*)(lds + 140048))[2]) != 0.f)
    const int nq = want_ctx ? 136 : 128;
    for (int k = 0; k < 8; ++k) {
        const int q = (x + k) & 7;
        for (;;) {
            const int i = mx_take(s_item, ctr + 1 + q);
            if (i >= nq) break;
            const bool fix = MX_FIX;
            AttnP p{};
            if (i < 64 || (i >= 128 && i < 132)) {
                if (i < 64) { const int bh = q + 8 * (i >> 4), qt = i & 15, bl = bh >> 3, hh = bh & 7;
                    p.Q = Qb + ((size_t)bh * SEQ + qt * 256) * 96; p.ntiles = 68; p.O = P + (size_t)(bl * SEQ + qt * 256) * NP + PC_AMLA + hh * 64;
                    p.Kb = Kb + (size_t)bh * TALL * 96; p.Vb = Vb + (size_t)bh * TALL * 64; }
                else { const int bh = q + 8 * (i - 128), bl = bh >> 3, hh = bh & 7;
                    p.Q = Qc + (size_t)bh * CTXL * 96; p.ntiles = 4; p.O = P + (size_t)(MG_LAT + bl * CTXL) * NP + PC_AMLA + hh * 64;
                    p.Kb = Kb + (size_t)bh * TALL * 96; p.Vb = Vb + (size_t)bh * TALL * 64; }
                p.q_ld = 96; p.o_ld = NP; p.C = MX_CMLA;
                if (fix) attn_unit<0, true>(lds, p); else attn_unit<0, false>(lds, p);
            } else {
                p.q_ld = NP; p.o_ld = NP; p.C = MX_CNA;
                if (i < 128) { const int u = i - 64, bh = q + 8 * (u >> 4), rb = u & 15, bl = bh >> 3, hh = bh & 7, r0 = rb * 4;
                    p.Q = P + (size_t)(bl * SEQ + r0 * 64) * NP + PC_NAQ + hh * 64; p.O = P + (size_t)(bl * SEQ + r0 * 64) * NP + PC_NAQ + hh * 64; p.r0 = r0;
                    p.rlo = min(max(r0 - 4, 0), 56); const int rhi = min(max(r0 + 3 - 4, 0), 56) + 7; p.nb = rhi - p.rlo + 1; p.ntiles = p.nb + 4;
                    p.Kb = P + (size_t)(bl * SEQ) * NP + PC_NAK + hh * 64; p.Vb = P + (size_t)(bl * SEQ) * NP + PC_NAV + hh * 64;
                    p.Kc = P + (size_t)(MG_LAT + bl * CTXL) * NP + PC_NAK + hh * 64; p.Vc = P + (size_t)(MG_LAT + bl * CTXL) * NP + PC_NAV + hh * 64;
                    p.rpb = a->in[22] + (size_t)(l * 8 + hh) * 465; }
                else { const int bh = q + 8 * (i - 132), bl = bh >> 3, hh = bh & 7;
                    p.Q = P + (size_t)(MG_LAT + bl * CTXL) * NP + PC_NAQ + hh * 64; p.O = P + (size_t)(MG_LAT + bl * CTXL) * NP + PC_NAQ + hh * 64;
                    p.r0 = 0; p.rlo = 0; p.nb = 0; p.ntiles = 4;
                    p.Kc = P + (size_t)(MG_LAT + bl * CTXL) * NP + PC_NAK + hh * 64; p.Vc = P + (size_t)(MG_LAT + bl * CTXL) * NP + PC_NAV + hh * 64;
                    p.Kb = p.Kc; p.Vb = p.Vc; p.rpb = a->in[22] + (size_t)(l * 8 + hh) * 465; }
                if (fix) attn_unit<1, true>(lds, p); else attn_unit<1, false>(lds, p);
            }
        }
    }
    mlC_phase(lds, P, ws, HD0, HD1);
}

__global__ void __launch_bounds__(512, 2) fwd_kernel(Args a_unused) {
    KArgs a = (KArgs)__builtin_amdgcn_kernarg_segment_ptr();
    extern __shared__ __attribute__((aligned(16))) unsigned char lds_raw[];
    cg::grid_group grid = cg::this_grid();
    char* lds = (char*)lds_raw;
    LAS unsigned char* ldsl = (LAS unsigned char*)lds_raw;
    const int G = gridDim.x, bid = blockIdx.x;
    { volatile LAS unsigned* st0 = (volatile LAS unsigned*)(lds_raw + 140032); if (threadIdx.x == 0) { st0[0] = 0u; st0[1] = 0u; } }
    __syncthreads();
    const XcdBarrier xbar = xcd_barrier_post((unsigned*)(a->ws + WS_CTL) + 4096, (volatile LAS unsigned*)(lds_raw + 140032));
#define GSYNC() xcd_barrier(xbar)
    unsigned char* ws = a->ws;
#define mod ((float*)(ws + WS_MOD))
#define xctx ((float*)(ws + WS_XCTX))
#define Hb ((bf16_t*)(ws + WS_H))
#define P ((bf16_t*)(ws + WS_P))
#define H2 ((bf16_t*)(ws + WS_H2))
#define U ((bf16_t*)(ws + WS_U))
#define Tb ((bf16_t*)(ws + WS_T))
#define Qb ((bf16_t*)(ws + WS_Q))
#define Qcb ((bf16_t*)(ws + WS_QC))
#define Kb ((bf16_t*)(ws + WS_K))
#define Vb ((bf16_t*)(ws + WS_V))
#define HD0 ((bf16_t*)(ws + WS_HD0))
#define HD1 ((bf16_t*)(ws + WS_HD1))
    if (bid < 192) mod_item(lds, a, bid);
    if (bid == 255 || (G < 256 && bid == 0)) { for (int i = threadIdx.x; i < 512; i += 512) { const int pos = i >> 3, f = i & 7; float sn, cs; sincosf((float)pos * expf(-(float)f * 0.125f * 9.210340371976184f), &sn, &cs);
        float* rt = (float*)(ws + WS_ROPE); rt[2 * i] = cs; rt[2 * i + 1] = sn; } }
    wconv_range(lds, a, bid, WT_LAYER, G);
    grid.sync();

#pragma unroll 1
    for (int l = 0; l < DEPTH; ++l) {
        asm volatile("" : "+s"(ws));
        const bool want_ctx = (l < DEPTH - 1);
#define modl (mod + (size_t)l * 9 * 6 * D)
#define wb (ws + WS_W + (size_t)l * W_LAYER)
#define xin_lat ((l == 0) ? a->in[0] : (const float*)a->out)
#define xin_ctx ((l == 0) ? a->in[2] : (const float*)xctx)
#pragma unroll 1
        for (int g = 0; g < NGROUP; ++g) {
            asm volatile("" : "+s"(ws));
            if (l == 1 && g == 0) {
                ctx_fixup(xctx, (const float*)(ws + WS_PART), mod + (size_t)NBATCH * 6 * D + 5 * D, 0, M_CTX);
                GSYNC();
            }
            norm_phase(xin_lat, xin_ctx, MG_LAT, MG, g * MG_LAT, g * MG_CTX, a->in[6] + l * D, modl, 0, D, Hb);
            GSYNC();
            if (want_ctx) { pg8::Gemm gm{Hb, D, (const bf16_t*)(wb + WO_IN), MG, NP, D}; pg8::StaticOrder S; S.init(MG, NP, G, bid);
              pg8::EpiStore E{P, NP, 0}; pg8::gemm_phase(ldsl, gm, S, E); }
            else { pg8::Gemm gm{Hb, D, (const bf16_t*)(wb + WO_IN), MG, NP, D}; pg8::CtxSkipOrder S; S.init(G, bid);
              pg8::EpiStore E{P, NP, 0}; pg8::gemm_phase(ldsl, gm, S, E); }
            if (l == 0 && bid >= 44) wconv_range(lds, a, WT_LAYER + g * (WT_LAYER / 2) + (bid - 44), WT_LAYER + (g + 1) * (WT_LAYER / 2), G - 44);
            GSYNC();
            { pg8::SplitOrder S; S.init(MG, TW, G, bid, 3); pg8::Gemm gm{P + PC_DQ, NP, (const bf16_t*)(wb + WO_UQ), MG, TW, 384, PC_DKV - PC_DQ, 0, 0};
              pg8::EpiStore E{Tb, TW, 0}; pg8::gemm_phase(ldsl, gm, S, E); }
            mlA_phase(lds, a, l, P, ws);
            GSYNC();
            prep_phase(a, l, want_ctx, P, Tb, Qb, Qcb, Kb, Vb, (const float*)(ws + WS_ROPE));
            mlB_phase(lds, ws);
            GSYNC();
            mixer_phase(lds, a, l, want_ctx, (unsigned*)(ws + WS_CTL) + (l * NGROUP + g) * 16, ws, P, Qb, Qcb, Kb, Vb, HD0, HD1);
            GSYNC();
            const int mrows = want_ctx ? MG : MG_LAT;
            mlcomb_phase(a, l, mrows, P, HD0, HD1);
            GSYNC();
            { pg8::MergeOrder S; S.init(mrows, D, G, bid);
              pg8::Gemm gm{P + PC_MLO, NP, (const bf16_t*)(wb + WO_MLWO), mrows, D, 512, PC_AMLA - PC_MLO, PC_NAQ - PC_MLO, D * 512};
              pg8::EpiMerge E{P}; pg8::gemm_phase(ldsl, gm, S, E); }
            GSYNC();
            { pg8::Gemm gm{P + PC_Z, NP, (const bf16_t*)(wb + WO_WOUT), mrows, D, D}; pg8::StaticOrder S; S.init(mrows, D, G, bid);
              pg8::EpiRes E{xin_lat, xin_ctx, a->out, xctx, modl, 2 * D, MG_LAT, g * MG_LAT, g * MG_CTX}; pg8::gemm_phase(ldsl, gm, S, E); }
            GSYNC();
        }
        const int frows = want_ctx ? M_ALL : M_LAT;
        norm_phase(a->out, xctx, M_LAT, frows, 0, 0, a->in[7] + l * D, modl, 3 * D, 4 * D, H2);
        GSYNC();
        { pg8::Gemm gm{H2, D, (const bf16_t*)(wb + WO_FF1), frows, DFF, D}; pg8::StaticOrder S; S.init(frows, DFF, G, bid);
          pg8::EpiStore E{U, DFF, 1}; pg8::gemm_phase(ldsl, gm, S, E); }
        GSYNC();
        { pg8::Gemm gm{U, DFF, (const bf16_t*)(wb + WO_FF2), M_LAT, D, DFF}; pg8::StaticOrder S; S.init(M_LAT, D, G, bid);
          pg8::EpiRes E{a->out, xctx, a->out, xctx, modl, 5 * D, M_LAT, 0, 0}; pg8::gemm_phase(ldsl, gm, S, E); }
        if (want_ctx) {
#pragma unroll 1
            for (int ks = 0; ks < 8; ++ks) {
                pg8::Gemm gm{U + (size_t)M_LAT * DFF + ks * 512, DFF, (const bf16_t*)(wb + WO_FF2) + ks * 512, M_CTX, D, 512, 0, 0, 0, DFF};
                pg8::StaticOrder S; S.init(M_CTX, D, G, (bid - 32 * ks + G) % G);
                pg8::EpiPartial E{(float*)(ws + WS_PART) + (size_t)ks * M_CTX * D}; pg8::gemm_phase(ldsl, gm, S, E);
            }
        }
        GSYNC();
    }
}

extern "C" void kernel_launch(void* const* d_in, const int* in_sizes, int n_in, void* d_out, int out_size, void* d_ws, size_t ws_size, hipStream_t stream) {
    static int grid = 0;
    if (grid == 0) {
        if (n_in != 27 || in_sizes[0] != M_LAT * D || out_size != M_LAT * D || ws_size < 512 * MiB) {
            fprintf(stderr, "kernel_launch: unexpected shapes (n_in %d, in0 %d, out %d, ws %zu); nothing launched\n", n_in, n_in > 0 ? in_sizes[0] : -1, out_size, ws_size); grid = -1; return; }
        int dev = 0, cus = 0, per_cu = 0;
        hipGetDevice(&dev); hipDeviceGetAttribute(&cus, hipDeviceAttributeMultiprocessorCount, dev);
        if (hipFuncSetAttribute((const void*)fwd_kernel, hipFuncAttributeMaxDynamicSharedMemorySize, LDS_BYTES) != hipSuccess) { fprintf(stderr, "hipFuncSetAttribute failed\n"); grid = -1; return; }
        hipOccupancyMaxActiveBlocksPerMultiprocessor(&per_cu, (const void*)fwd_kernel, 512, LDS_BYTES);
        if (per_cu < 1) { fprintf(stderr, "occupancy query says %d blocks/CU\n", per_cu); per_cu = 1; }
        (void)hipGetLastError();
        grid = cus;
    }
    if (grid < 0) return;
    (void)hipMemsetAsync((char*)d_ws + WS_CTL, 0, 65536, stream);
    Args a{};
    for (int i = 0; i < 27; ++i) a.in[i] = (const float*)d_in[i];
    a.out = (float*)d_out; a.ws = (unsigned char*)d_ws;
    void* args[] = {&a};
    hipError_t e = hipLaunchCooperativeKernel((const void*)fwd_kernel, dim3(grid), dim3(512), args, LDS_BYTES, stream);
    if (e != hipSuccess) fprintf(stderr, "cooperative launch failed: %s (grid %d)\n", hipGetErrorString(e), grid);
}
```

```cpp
#include <hip/hip_runtime.h>
#include <hip/hip_cooperative_groups.h>
#include <cstdio>
#include <cstdint>
namespace cg = cooperative_groups;

#define DI __device__ __forceinline__
#define LAS __attribute__((address_space(3)))
typedef unsigned short bf16_t;
typedef short bf16x8 __attribute__((ext_vector_type(8)));
typedef float f32x4 __attribute__((ext_vector_type(4)));
typedef float f32x16 __attribute__((ext_vector_type(16)));
typedef float f32x2_t __attribute__((ext_vector_type(2)));
typedef __bf16 bf16x2_t __attribute__((ext_vector_type(2)));
typedef unsigned u32x4 __attribute__((ext_vector_type(4)));
typedef unsigned u32x2 __attribute__((ext_vector_type(2)));

constexpr int D = 1024, NBATCH = 8, SEQ = 4096, CTXL = 256, DFF = 4096, DEPTH = 2;
constexpr int GB = 4, NGROUP = 2;
constexpr int MG_LAT = GB * SEQ, MG_CTX = GB * CTXL, MG = MG_LAT + MG_CTX;
constexpr int M_LAT = NBATCH * SEQ, M_CTX = NBATCH * CTXL, M_ALL = M_LAT + M_CTX;
constexpr int D_IN = 6832, NP = 6912;
constexpr int TALL = CTXL + SEQ;
constexpr int PC_MLQ = 0, PC_MLK = 256, PC_MLV = 512, PC_MLO = 1024, PC_NAQ = 1536, PC_NAK = 2048, PC_NAV = 2560,
              PC_DQ = 3072, PC_DKV = 3456, PC_KR = 3712, PC_GT = 3744, PC_MG = 3840;
constexpr int PC_AMLA = 3072, PC_Z = 2048;
constexpr int TW = 1792;
constexpr float EPS = 1e-6f;
constexpr float LOG2E = 1.4426950408889634f;

constexpr size_t MiB = 1u << 20;
constexpr size_t WS_CTL = 0, WS_ROPE = 512 * 1024, WS_MOD = 1 * MiB, WS_W = 2 * MiB, W_LAYER = 36 * MiB;
constexpr size_t WO_IN = 0, WO_MLWO = 13 * MiB + 512 * 1024, WO_MLAWO = WO_MLWO + 1 * MiB, WO_NAWO = WO_MLAWO + 1 * MiB, WO_UQ = WO_NAWO + 1 * MiB, WO_UKV = WO_UQ + 576 * 1024,
                 WO_WOUT = WO_UKV + 768 * 1024, WO_FF1 = WO_WOUT + 2 * MiB, WO_FF2 = WO_FF1 + 8 * MiB;
static_assert(WO_FF2 + 8 * MiB <= W_LAYER, "weights");
constexpr size_t WS_XCTX = 74 * MiB, WS_QC = 82 * MiB, WS_REG = 84 * MiB;
constexpr size_t WS_H = WS_REG, WS_P = 118 * MiB, WS_Q = 348 * MiB, WS_K = 372 * MiB, WS_V = 398 * MiB, WS_HD0 = 415 * MiB, WS_HD1 = 432 * MiB, WS_T = 415 * MiB;
constexpr size_t WS_ANA = 450 * MiB;
constexpr size_t WS_PART = 424 * MiB;
constexpr size_t WS_H2 = WS_REG, WS_U = 152 * MiB;
constexpr size_t WS_END = 511 * MiB;
static_assert(WS_P + (size_t)MG * NP * 2 <= WS_Q && WS_T + (size_t)MG * TW * 2 <= WS_END && WS_U + (size_t)M_ALL * DFF * 2 <= WS_END, "ws map");

constexpr int LDS_BYTES = 147456;

DI unsigned pk2(float lo, float hi) { f32x2_t v = {lo, hi}; bf16x2_t b = __builtin_convertvector(v, bf16x2_t); return __builtin_bit_cast(unsigned, b); }
DI bf16_t f2bf(float f) { return (bf16_t)(pk2(f, 0.f) & 0xffffu); }
DI float bf2f(bf16_t v) { return __uint_as_float(((unsigned)v) << 16); }
DI float bflo(unsigned w) { return __uint_as_float(w << 16); }
DI float bfhi(unsigned w) { return __uint_as_float(w & 0xffff0000u); }
template <int CTRL> DI float dpp_f(float v) { return __int_as_float(__builtin_amdgcn_update_dpp(0, __float_as_int(v), CTRL, 0xF, 0xF, true)); }
DI float sum4(float v) { v += dpp_f<0xB1>(v); v += dpp_f<0x4E>(v); return v; }
DI float sum8(float v) { v = sum4(v); v += dpp_f<0x141>(v); return v; }
DI float sum16(float v) { v = sum8(v); v += dpp_f<0x140>(v); return v; }
DI float wave_sum(float v) {
    v = sum16(v);
    const int iv = __float_as_int(v);
    return (__int_as_float(__builtin_amdgcn_readlane(iv, 0)) + __int_as_float(__builtin_amdgcn_readlane(iv, 16))) + (__int_as_float(__builtin_amdgcn_readlane(iv, 32)) + __int_as_float(__builtin_amdgcn_readlane(iv, 48)));
}
DI float shx(float v, int lane, int m) { return __int_as_float(__builtin_amdgcn_ds_bpermute((lane ^ m) << 2, __float_as_int(v))); }
DI float shu(float v, int lane, int d) { return __int_as_float(__builtin_amdgcn_ds_bpermute(((lane - d) & 63) << 2, __float_as_int(v))); }
DI float rdl63(float v) { return __int_as_float(__builtin_amdgcn_readlane(__float_as_int(v), 63)); }
template <class T> DI T ntload(const T* p) { return __builtin_nontemporal_load(p); }
DI float sigmoidf_(float x) { return __builtin_amdgcn_rcpf(1.f + __expf(-x)); }

namespace pg8 {
constexpr int BM = 256, BK = 64, HALF = 128, HTB = HALF * BK * 2, NXCD = 8, WGM = 8;
DI int lds_byte(int r, int c) { const int st = (r >> 4) * 2 + (c >> 5), rr = r & 15, cc = c & 31, ob = rr * 64 + cc * 2; return st * 1024 + (ob ^ (((ob >> 9) & 1) << 5)); }
DI void stage_rc(int b, int& R, int& C) { const int st = b / 1024, sb = b % 1024, swz = sb ^ (((sb >> 9) & 1) << 5); R = (st >> 1) * 16 + swz / 64; C = (st & 1) * 32 + (swz % 64) / 2; }
DI int perm32(int rho) { const int n = rho >> 4, i = rho & 15; return 8 * (i >> 2) + 4 * n + (i & 3); }
struct Unit { int pm, pn, br; };
struct Gemm { const bf16_t* A; int lda; const bf16_t* Bt; int M, N, K; int a1 = 0, a2 = 0; int bbr = 0; int ldb = 0; };
struct StaticOrder {
    int nM, nN, nwg, G, c;
    DI void init(int M, int N, int G_, int c_) { nM = M / BM; nN = N / BM; nwg = nM * nN; G = G_; c = c_; }
    DI bool next(int i, Unit& u) const {
        const long L = (long)i * G + c; if (L >= nwg) return false;
        int wgid = (int)L; { const int q = nwg / NXCD, r = nwg % NXCD, xcd = wgid % NXCD, off = wgid / NXCD; wgid = (xcd < r ? xcd * (q + 1) : r * (q + 1) + (xcd - r) * q) + off; }
        const int nig = WGM * nN, gid = wgid / nig, fm = gid * WGM, gsz = (nM - fm) < WGM ? (nM - fm) : WGM;
        u.pm = fm + ((wgid % nig) % gsz); u.pn = (wgid % nig) / gsz; u.br = 0; return true;
    }
    DI bool keep(const Unit&) const { return false; }
};
struct CtxSkipOrder {
    StaticOrder T; int G, c;
    DI void init(int G_, int c_) { T.init(MG_LAT, NP, G_, c_); G = G_; c = c_; }
    DI bool next(int i, Unit& u) const {
        const int L = i * G + c;
        if (L < 64 * 27) return T.next(i, u);
        const int x = L - 64 * 27; if (x >= 36) return false;
        const int q = x / 9, k = x - 9 * q;
        u.pm = 64 + q; u.pn = (k < 3) ? 1 + k : (k < 7 ? 5 + k : 6 + k); u.br = 0; return true;
    }
    DI bool keep(const Unit&) const { return false; }
};
struct SplitOrder {
    StaticOrder T; int split;
    DI void init(int M, int N, int G_, int c_, int split_) { T.init(M, N, G_, c_); split = split_; }
    DI bool next(int i, Unit& u) const { if (!T.next(i, u)) return false; u.br = (u.pn >= split) ? 1 : 0; return true; }
    DI bool keep(const Unit&) const { return false; }
};
struct MergeOrder {
    StaticOrder T;
    DI void init(int M, int N, int G_, int c_) { T.init(M, N, G_, c_); }
    DI bool next(int i, Unit& u) const { const int t = i / 3; if (!T.next(t, u)) return false; u.br = i - 3 * t; return true; }
    DI bool keep(const Unit& u) const { return u.br < 2; }
};
#define PG8_ABASE(u) ((const char*)g.A + (size_t)(u).pm * tstepA + (size_t)((u).br == 0 ? 0 : ((u).br == 1 ? g.a1 : g.a2)) * 2)
#define PG8_BBASE(u) ((const char*)g.Bt + (size_t)(u).pn * tstepB + (size_t)(u).br * g.bbr * 2)
template <class Epi, class Sched>
DI void gemm_phase(LAS unsigned char* lds, const Gemm g, const Sched& S, const Epi& E) {
    int tid = threadIdx.x; asm volatile("" : "+v"(tid));
    const int wid = __builtin_amdgcn_readfirstlane(tid >> 6), lane = tid & 63, wr = wid >> 2, wc = wid & 3, fr = lane & 15, fq = lane >> 4;
    const int K = g.K, nt = K / BK, lda = g.lda, ldb = g.ldb ? g.ldb : g.K;
    unsigned voffA[2], voffB[2];
#pragma unroll
    for (int i = 0; i < 2; ++i) { int R, C; stage_rc(tid * 16 + i * 8192, R, C); const int Rb = (R & ~31) + perm32(R & 31);
        voffA[i] = (unsigned)(R * lda + C) * 2u; voffB[i] = (unsigned)(Rb * ldb + C) * 2u; }
    const size_t kstep = (size_t)(BK * 2);
    const size_t hstepA = (size_t)HALF * lda * 2, hstepB = (size_t)HALF * ldb * 2;
    const size_t tstepA = 2 * hstepA, tstepB = 2 * hstepB;
    const unsigned ldsw = (unsigned)wid * 1024u;
    const int aoff = lds_byte(wr * 64 + fr, fq * 8), boff = lds_byte(wc * 32 + fr, fq * 8);
#define PG8_SA(b, h) (((b) * 2 + (h)) * HTB)
#define PG8_SB(b, h) ((4 + (b) * 2 + (h)) * HTB)
#define PG8_STAGE(bufoff, gbase, voff) do { _Pragma("unroll") for (int _i = 0; _i < 2; ++_i) \
        __builtin_amdgcn_global_load_lds((const unsigned*)((const char*)(gbase) + (voff)[_i]), (LAS unsigned*)(lds + (bufoff) + ldsw + _i * 8192), 16, 0, 0); } while (0)
#define PG8_LDA(dst, b, h) do { _Pragma("unroll") for (int m = 0; m < 4; ++m) _Pragma("unroll") for (int k = 0; k < 2; ++k) dst[m][k] = *(const LAS bf16x8*)(lds + PG8_SA(b, h) + aoff + m * 2048 + k * 1024); } while (0)
#define PG8_LDB(dst, b, h) do { _Pragma("unroll") for (int n = 0; n < 2; ++n) _Pragma("unroll") for (int k = 0; k < 2; ++k) dst[n][k] = *(const LAS bf16x8*)(lds + PG8_SB(b, h) + boff + n * 2048 + k * 1024); } while (0)
#define PG8_MMA(ai, bj, At, Bt) do { __builtin_amdgcn_s_setprio(1); _Pragma("unroll") for (int m = 0; m < 4; ++m) _Pragma("unroll") for (int n = 0; n < 2; ++n) _Pragma("unroll") for (int k = 0; k < 2; ++k) \
        acc[ai][bj][m][n] = __builtin_amdgcn_mfma_f32_16x16x32_bf16(Bt[n][k], At[m][k], acc[ai][bj][m][n], 0, 0, 0); __builtin_amdgcn_s_setprio(0); } while (0)
#define PG8_WAIT_V(n) asm volatile("s_waitcnt vmcnt(" #n ")" ::: "memory")
#define PG8_WAIT_L(n) asm volatile("s_waitcnt lgkmcnt(" #n ")" ::: "memory")
#define PG8_BAR __builtin_amdgcn_s_barrier()
#define PG8_SCHED __builtin_amdgcn_sched_barrier(0)
    Unit cur, nxt; int ui = 0;
    if (!S.next(0, cur)) return;
    f32x4 acc[2][2][4][2];
#pragma unroll
    for (int a = 0; a < 2; ++a)
#pragma unroll
        for (int b = 0; b < 2; ++b)
#pragma unroll
            for (int m = 0; m < 4; ++m)
#pragma unroll
                for (int n = 0; n < 2; ++n) acc[a][b][m][n] = (f32x4){0.f, 0.f, 0.f, 0.f};
    bf16x8 At[4][2], B0[2][2], B1[2][2];
    const char* cA = PG8_ABASE(cur); const char* cB = PG8_BBASE(cur);
    PG8_STAGE(PG8_SB(0, 0), cB, voffB); PG8_STAGE(PG8_SB(0, 1), cB + hstepB, voffB); PG8_STAGE(PG8_SA(0, 0), cA, voffA); PG8_STAGE(PG8_SA(0, 1), cA + hstepA, voffA);
    if (wr == 1) PG8_BAR;
    PG8_WAIT_V(2); PG8_BAR;
    PG8_STAGE(PG8_SB(1, 0), cB + kstep, voffB); PG8_STAGE(PG8_SA(1, 0), cA + kstep, voffA); PG8_STAGE(PG8_SB(1, 1), cB + hstepB + kstep, voffB);
    PG8_WAIT_V(6); PG8_BAR;
    for (;;) {
        const bool has_next = S.next(ui + 1, nxt);
        const char* nA = has_next ? PG8_ABASE(nxt) : cA; const char* nB = has_next ? PG8_BBASE(nxt) : cB;
        for (int t = 0; t < nt; t += 2) {
            const bool last = (t == nt - 2);
            const char* a1 = cA + (size_t)(t + 1) * kstep;
            const char* a2 = last ? nA : cA + (size_t)(t + 2) * kstep; const char* b2 = last ? nB : cB + (size_t)(t + 2) * kstep;
            const char* a3 = a2 + kstep; const char* b3 = b2 + kstep;
            PG8_LDB(B0, 0, 0); PG8_LDB(B1, 0, 1); PG8_SCHED; PG8_LDA(At, 0, 0); PG8_STAGE(PG8_SA(1, 1), a1 + hstepA, voffA);
            PG8_WAIT_V(8); PG8_WAIT_L(0); PG8_BAR; PG8_MMA(0, 0, At, B0); PG8_MMA(0, 1, At, B1); PG8_BAR; PG8_SCHED;
            PG8_LDA(At, 0, 1); PG8_STAGE(PG8_SB(0, 0), b2, voffB); PG8_STAGE(PG8_SB(0, 1), b2 + hstepB, voffB); PG8_STAGE(PG8_SA(0, 0), a2, voffA);
            PG8_WAIT_V(8); PG8_WAIT_L(0); PG8_BAR; PG8_MMA(1, 0, At, B0); PG8_MMA(1, 1, At, B1); PG8_BAR; PG8_SCHED;
            PG8_LDB(B0, 1, 0); PG8_LDB(B1, 1, 1); PG8_SCHED; PG8_LDA(At, 1, 0); PG8_STAGE(PG8_SA(0, 1), a2 + hstepA, voffA);
            PG8_WAIT_V(8); PG8_WAIT_L(0); PG8_BAR; PG8_MMA(0, 0, At, B0); PG8_MMA(0, 1, At, B1); PG8_BAR; PG8_SCHED;
            PG8_LDA(At, 1, 1); PG8_STAGE(PG8_SB(1, 0), b3, voffB); PG8_STAGE(PG8_SB(1, 1), b3 + hstepB, voffB); PG8_STAGE(PG8_SA(1, 0), a3, voffA);
            PG8_WAIT_V(8); PG8_WAIT_L(0); PG8_BAR; PG8_MMA(1, 0, At, B0); PG8_MMA(1, 1, At, B1); PG8_BAR; PG8_SCHED;
        }
        if (wr == 0) PG8_BAR;
        { int t2 = threadIdx.x; asm volatile("" : "+v"(t2)); E(acc, cur, wr, wc, t2 & 15, (t2 & 63) >> 4); }
        if (!has_next) break;
        if (!S.keep(cur)) {
#pragma unroll
        for (int a = 0; a < 2; ++a)
#pragma unroll
            for (int b = 0; b < 2; ++b)
#pragma unroll
                for (int m = 0; m < 4; ++m)
#pragma unroll
                    for (int n = 0; n < 2; ++n) acc[a][b][m][n] = (f32x4){0.f, 0.f, 0.f, 0.f};
        }
        cur = nxt; cA = nA; cB = nB; ++ui;
        if (wr == 1) PG8_BAR;
    }
    PG8_WAIT_V(0);
    PG8_BAR;
#undef PG8_SA
#undef PG8_SB
#undef PG8_STAGE
#undef PG8_LDA
#undef PG8_LDB
#undef PG8_MMA
#undef PG8_WAIT_V
#undef PG8_WAIT_L
#undef PG8_BAR
#undef PG8_SCHED
}

struct EpiStore {
    bf16_t* O; int ldc; int act;
    DI void operator()(const f32x4 (&acc)[2][2][4][2], const Unit& u, int wr, int wc, int fr, int fq) const {
        const int row0 = u.pm * BM + wr * 64 + fr, col0 = u.pn * BM + wc * 32 + 8 * fq;
#pragma unroll
        for (int ai = 0; ai < 2; ++ai)
#pragma unroll
            for (int m = 0; m < 4; ++m) { bf16_t* rowp = O + (size_t)(row0 + ai * HALF + m * 16) * ldc + col0;
#pragma unroll
                for (int bj = 0; bj < 2; ++bj) { f32x4 v0 = acc[ai][bj][m][0], v1 = acc[ai][bj][m][1];
                    if (act == 1) {
#pragma unroll
                        for (int j = 0; j < 4; ++j) { float a = fmaxf(v0[j], 0.f), b = fmaxf(v1[j], 0.f); v0[j] = a * a; v1[j] = b * b; } }
                    u32x4 w; w.x = pk2(v0[0], v0[1]); w.y = pk2(v0[2], v0[3]); w.z = pk2(v1[0], v1[1]); w.w = pk2(v1[2], v1[3]);
                    *(u32x4*)(rowp + bj * HALF) = w; } }
    }
};
struct EpiMerge {
    bf16_t* P;
    DI void operator()(f32x4 (&acc)[2][2][4][2], const Unit& u, int wr, int wc, int fr, int fq) const {
        const int row0 = u.pm * BM + wr * 64 + fr, col0 = u.pn * BM + wc * 32 + 8 * fq;
        const int gc = PC_MG + u.br * D;
#pragma unroll
        for (int ai = 0; ai < 2; ++ai)
#pragma unroll
            for (int m = 0; m < 4; ++m) { bf16_t* rowp = P + (size_t)(row0 + ai * HALF + m * 16) * NP;
#pragma unroll
                for (int bj = 0; bj < 2; ++bj) { const int c = col0 + bj * HALF;
                    const u32x4 ga = *(const u32x4*)(rowp + gc + c);
                    float xa[8]; xa[0] = bflo(ga.x); xa[1] = bfhi(ga.x); xa[2] = bflo(ga.y); xa[3] = bfhi(ga.y); xa[4] = bflo(ga.z); xa[5] = bfhi(ga.z); xa[6] = bflo(ga.w); xa[7] = bfhi(ga.w);
                    f32x4& v0 = acc[ai][bj][m][0]; f32x4& v1 = acc[ai][bj][m][1];
                    if (u.br < 2) {
                        const u32x4 gb = *(const u32x4*)(rowp + gc + D + c);
                        float xb[8]; xb[0] = bflo(gb.x); xb[1] = bfhi(gb.x); xb[2] = bflo(gb.y); xb[3] = bfhi(gb.y); xb[4] = bflo(gb.z); xb[5] = bfhi(gb.z); xb[6] = bflo(gb.w); xb[7] = bfhi(gb.w);
#pragma unroll
                        for (int j = 0; j < 4; ++j) { v0[j] *= (1.f + __expf(-xb[j])) * __builtin_amdgcn_rcpf(1.f + __expf(-xa[j])); v1[j] *= (1.f + __expf(-xb[4 + j])) * __builtin_amdgcn_rcpf(1.f + __expf(-xa[4 + j])); }
                    } else {
                        u32x4 w; w.x = pk2(v0[0] * sigmoidf_(xa[0]), v0[1] * sigmoidf_(xa[1])); w.y = pk2(v0[2] * sigmoidf_(xa[2]), v0[3] * sigmoidf_(xa[3]));
                        w.z = pk2(v1[0] * sigmoidf_(xa[4]), v1[1] * sigmoidf_(xa[5])); w.w = pk2(v1[2] * sigmoidf_(xa[6]), v1[3] * sigmoidf_(xa[7]));
                        *(u32x4*)(rowp + PC_Z + c) = w;
                    } } }
    }
};
struct EpiRes {
    const float* src_lat; const float* src_ctx; float* dst_lat; float* dst_ctx; const float* modl; int goff; int nlat, latoff, ctxoff;
    DI void operator()(const f32x4 (&acc)[2][2][4][2], const Unit& u, int wr, int wc, int fr, int fq) const {
        const int row0 = u.pm * BM + wr * 64 + fr, col0 = u.pn * BM + wc * 32 + 8 * fq;
        const int trow = u.pm * BM;
        const bool lat = trow < nlat;
        const int b = lat ? (latoff + trow) / SEQ : NBATCH;
        const float* gate = modl + (size_t)b * 6 * D + goff;
        const float* sb = lat ? src_lat + (long)latoff * D : src_ctx + ((long)ctxoff - nlat) * D;
        float* db = lat ? dst_lat + (long)latoff * D : dst_ctx + ((long)ctxoff - nlat) * D;
        f32x4 gv[2][2];
#pragma unroll
        for (int bj = 0; bj < 2; ++bj)
#pragma unroll
            for (int n = 0; n < 2; ++n) gv[bj][n] = *(const f32x4*)(gate + col0 + bj * HALF + 4 * n);
#pragma unroll
        for (int ai = 0; ai < 2; ++ai)
#pragma unroll
            for (int m = 0; m < 4; ++m) { const size_t ro = (size_t)(row0 + ai * HALF + m * 16) * D + col0;
#pragma unroll
                for (int bj = 0; bj < 2; ++bj)
#pragma unroll
                    for (int n = 0; n < 2; ++n) { const f32x4 s = *(const f32x4*)(sb + ro + bj * HALF + 4 * n);
                        *(f32x4*)(db + ro + bj * HALF + 4 * n) = s + gv[bj][n] * acc[ai][bj][m][n]; } }
    }
};
struct EpiPartial {
    float* dst;
    DI void operator()(const f32x4 (&acc)[2][2][4][2], const Unit& u, int wr, int wc, int fr, int fq) const {
        const int row0 = u.pm * BM + wr * 64 + fr, col0 = u.pn * BM + wc * 32 + 8 * fq;
#pragma unroll
        for (int ai = 0; ai < 2; ++ai)
#pragma unroll
            for (int m = 0; m < 4; ++m) { float* rp = dst + (size_t)(row0 + ai * HALF + m * 16) * D + col0;
#pragma unroll
                for (int bj = 0; bj < 2; ++bj)
#pragma unroll
                    for (int n = 0; n < 2; ++n) *(f32x4*)(rp + bj * HALF + 4 * n) = acc[ai][bj][m][n]; }
    }
};
}


#define XB_TMO      128
#define XB_XCNT(j)  (256  + 64 * (j))
#define XB_XSUB(j)  (1280 + 64 * (j))
#define XB_XGEN(j)  (2304 + 64 * (j))
#define XB_TOP      3328
#define XB_TOPGEN   3392
#define XCD_BAR_WORDS 3456
#define XB_SPIN_CAP (1u << 22)
DI unsigned xb_ld(unsigned* p)              { return __hip_atomic_load(p, __ATOMIC_RELAXED, __HIP_MEMORY_SCOPE_AGENT); }
DI unsigned xb_add(unsigned* p, unsigned v) { return __hip_atomic_fetch_add(p, v, __ATOMIC_RELAXED, __HIP_MEMORY_SCOPE_AGENT); }
DI unsigned xb_xcc_id() { return (unsigned)__builtin_amdgcn_s_getreg((3 << 11) | 20) & 0xFu; }
#define XB_SPIN(cond, bar) do { unsigned _sp = 0; while (cond) { __builtin_amdgcn_s_sleep(1); \
    if ((++_sp & 255u) == 0u) { if (xb_ld(&(bar)[XB_TMO])) break; if (_sp > XB_SPIN_CAP) { atomicAdd(&(bar)[XB_TMO], 1u); break; } } } } while (0)
struct XcdBarrier { unsigned* bar; unsigned x; volatile LAS unsigned* st; };
DI XcdBarrier xcd_barrier_post(unsigned* bar, volatile LAS unsigned* st) {
    XcdBarrier b; b.bar = bar; b.x = xb_xcc_id(); b.st = st;
    if (threadIdx.x == 0) (void)xb_add(&bar[XB_XCNT(b.x)], 1u);
    return b;
}
DI void xcd_barrier_complete(unsigned* bar, unsigned x, unsigned& nloc, unsigned& nx) {
    const unsigned G = gridDim.x * gridDim.y * gridDim.z;
    unsigned sum, cnt, mine, sp = 0u;
    for (;;) {
        sum = 0u; cnt = 0u; mine = 0u;
#pragma unroll
        for (unsigned j = 0; j < 16; ++j) { const unsigned c = xb_ld(&bar[XB_XCNT(j)]); sum += c; cnt += (c > 0u) ? 1u : 0u; mine = (j == x) ? c : mine; }
        if (sum == G) break;
        __builtin_amdgcn_s_sleep(1);
        if ((++sp & 255u) == 0u) { if (xb_ld(&bar[XB_TMO])) break; if (sp > XB_SPIN_CAP) { atomicAdd(&bar[XB_TMO], 1u); break; } }
    }
    nloc = mine > 0u ? mine : 1u; nx = cnt > 0u ? cnt : 1u;
}
DI void xcd_barrier(const XcdBarrier& b) {
    asm volatile("s_waitcnt vmcnt(0)" ::: "memory");
    __syncthreads();
    if (threadIdx.x == 0) {
        unsigned* bar = b.bar;
        __builtin_amdgcn_s_waitcnt(0);
        unsigned nloc = b.st[0], nx = b.st[1];
        if (nloc == 0u) { xcd_barrier_complete(bar, b.x, nloc, nx); b.st[0] = nloc; b.st[1] = nx; }
        const unsigned old = xb_add(&bar[XB_XSUB(b.x)], 1u);
        const unsigned gen = old / nloc;
        if (old + 1u == (gen + 1u) * nloc) {
            __builtin_amdgcn_fence(__ATOMIC_RELEASE, "agent");
            asm volatile("s_waitcnt vmcnt(0)" ::: "memory");
            const unsigned og = xb_add(&bar[XB_TOP], 1u);
            const unsigned tg = og / nx;
            if (og + 1u == (tg + 1u) * nx) xb_add(&bar[XB_TOPGEN], 1u);
            else XB_SPIN(xb_ld(&bar[XB_TOPGEN]) == tg, bar);
            __builtin_amdgcn_fence(__ATOMIC_ACQUIRE, "agent");
            xb_add(&bar[XB_XGEN(b.x)], 1u);
            asm volatile("s_waitcnt vmcnt(0)" ::: "memory");
        } else {
            XB_SPIN(xb_ld(&bar[XB_XGEN(b.x)]) == gen, bar);
            __builtin_amdgcn_fence(__ATOMIC_ACQUIRE, "agent");
            asm volatile("s_waitcnt vmcnt(0)" ::: "memory");
        }
    }
    __syncthreads();
}

struct Args {
    const float* in[27];
    float* out; unsigned char* ws;
};
typedef const __attribute__((address_space(4))) Args* KArgs;

DI int win_src_col(int np) {
    if (np < 1536) return np;
    if (np < 3072) return np + 688;
    if (np < 3744) return np - 3072 + 1552;
    if (np < 3760) return np - 3744 + 1536;
    if (np < 3840) return -1;
    return np - 80;
}
struct WJob { const float* src; bf16_t* dst; const float* rs; int K, N, kt, nt, mode; };
DI void wconv_load(const WJob& j, float (&v)[8]) {
    int tid = threadIdx.x; asm volatile("" : "+v"(tid));
    const int nl = tid & 63, ks = tid >> 6;
    const int np = j.nt * 64 + nl;
    const int sc = (j.mode == 1) ? win_src_col(np) : np;
#pragma unroll
    for (int kk = 0; kk < 8; ++kk) { const int k = j.kt * 64 + ks * 8 + kk; float x = 0.f;
        if (j.mode == 2) { v[kk] = 0.f; continue; }
        if (sc >= 0) x = j.src[(size_t)k * j.N + sc];
        if (j.rs) x *= j.rs[k];
        v[kk] = x; }
}
DI void wconv_store(char* lds, const WJob& j, const float (&v)[8]) {
    float* tile = (float*)lds;
    int tid = threadIdx.x; asm volatile("" : "+v"(tid));
    const int nl = tid & 63, ks = tid >> 6;
    __syncthreads();
#pragma unroll
    for (int kk = 0; kk < 8; ++kk) tile[(ks * 8 + kk) * 65 + nl] = v[kk];
    __syncthreads();
    const int n2 = tid >> 3, kseg = tid & 7;
    float o[8];
#pragma unroll
    for (int q = 0; q < 8; ++q) o[q] = tile[(kseg * 8 + q) * 65 + n2];
    u32x4 w; w.x = pk2(o[0], o[1]); w.y = pk2(o[2], o[3]); w.z = pk2(o[4], o[5]); w.w = pk2(o[6], o[7]);
    *(u32x4*)(j.dst + (size_t)(j.nt * 64 + n2) * j.K + j.kt * 64 + kseg * 8) = w;
}
constexpr int WT_IN = 108 * 16, WT_MLWO = 16 * 8, WT_UQ = 12 * 6, WT_UKV = 16 * 6, WT_MLAWO = 16 * 8, WT_NAWO = 16 * 8, WT_WOUT = 16 * 16, WT_FF1 = 64 * 16, WT_FF2 = 16 * 64;
constexpr int WT_LAYER = WT_IN + WT_MLWO + WT_UQ + WT_UKV + WT_MLAWO + WT_NAWO + WT_WOUT + WT_FF1 + WT_FF2;
DI WJob wconv_decode(KArgs a, int item) {
    const int l = item / WT_LAYER; int r = item % WT_LAYER;
    unsigned char* wb = a->ws + WS_W + (size_t)l * W_LAYER;
    WJob j; j.mode = 0; j.rs = nullptr; int NT;
    if (r < WT_IN) { j.src = a->in[8] + (size_t)l * D * D_IN; j.dst = (bf16_t*)(wb + WO_IN); j.K = D; j.N = D_IN; NT = 108; j.mode = 1; }
    else if ((r -= WT_IN) < WT_MLWO) { j.src = a->in[12] + (size_t)l * 512 * D; j.dst = (bf16_t*)(wb + WO_MLWO); j.K = 512; j.N = D; NT = 16; }
    else if ((r -= WT_MLWO) < WT_UQ) { j.src = a->in[14] + (size_t)l * 384 * 768; j.dst = (bf16_t*)(wb + WO_UQ); j.K = 384; j.N = 768; NT = 12; j.rs = a->in[13] + l * 384; }
    else if ((r -= WT_UQ) < WT_UKV) { j.src = a->in[16] + (size_t)l * 256 * 1024; j.dst = (bf16_t*)(wb + WO_UKV); j.K = 384; j.N = 1024; NT = 16; j.rs = a->in[15] + l * 256; if (r >= 16 * 4) j.mode = 2; }
    else if ((r -= WT_UKV) < WT_MLAWO) { j.src = a->in[19] + (size_t)l * 512 * D; j.dst = (bf16_t*)(wb + WO_MLAWO); j.K = 512; j.N = D; NT = 16; }
    else if ((r -= WT_MLAWO) < WT_NAWO) { j.src = a->in[23] + (size_t)l * 512 * D; j.dst = (bf16_t*)(wb + WO_NAWO); j.K = 512; j.N = D; NT = 16; }
    else if ((r -= WT_NAWO) < WT_WOUT) { j.src = a->in[24] + (size_t)l * D * D; j.dst = (bf16_t*)(wb + WO_WOUT); j.K = D; j.N = D; NT = 16; }
    else if ((r -= WT_WOUT) < WT_FF1) { j.src = a->in[25] + (size_t)l * D * DFF; j.dst = (bf16_t*)(wb + WO_FF1); j.K = D; j.N = DFF; NT = 64; }
    else { r -= WT_FF1; j.src = a->in[26] + (size_t)l * DFF * D; j.dst = (bf16_t*)(wb + WO_FF2); j.K = DFF; j.N = D; NT = 16; }
    j.nt = r % NT; j.kt = r / NT;
    return j;
}
DI void wconv_range(char* lds, KArgs a, int first, int last, int stride) {
    int it = first; float v[8];
    if (it < last) { const WJob j = wconv_decode(a, it); wconv_load(j, v); }
    while (it < last) {
        const WJob j = wconv_decode(a, it);
        const int nx = it + stride; float v2[8];
#pragma unroll
        for (int q = 0; q < 8; ++q) v2[q] = 0.f;
        if (nx < last) { const WJob jn = wconv_decode(a, nx); wconv_load(jn, v2); }
        wconv_store(lds, j, v);
#pragma unroll
        for (int q = 0; q < 8; ++q) v[q] = v2[q];
        it = nx;
    }
    __syncthreads();
}
DI void mod_item(char* lds, KArgs a, int item) {
    float* sv = (float*)lds;
    float* red = sv + 9 * 1024;
    const int tid = threadIdx.x, l = item / 96, n0 = (item % 96) * 64;
    for (int i = tid; i < 9 * 1024; i += 512) { const float c = (i < 8 * 1024) ? a->in[1][i] : a->in[3][i - 8 * 1024]; sv[i] = c / (1.f + __expf(-c)); }
    __syncthreads();
    const int kg = tid >> 6, c = tid & 63;
    const float* w = a->in[4] + (size_t)l * D * 6 * D + n0 + c;
    float acc[9];
#pragma unroll
    for (int r = 0; r < 9; ++r) acc[r] = 0.f;
    for (int k0 = kg; k0 < D; k0 += 64) { float wv[8];
#pragma unroll
        for (int q = 0; q < 8; ++q) wv[q] = w[(size_t)(k0 + 8 * q) * 6 * D];
#pragma unroll
        for (int q = 0; q < 8; ++q)
#pragma unroll
            for (int r = 0; r < 9; ++r) acc[r] += sv[r * 1024 + k0 + 8 * q] * wv[q]; }
#pragma unroll
    for (int r = 0; r < 9; ++r) red[(kg * 9 + r) * 64 + c] = acc[r];
    __syncthreads();
    float* mod = (float*)(a->ws + WS_MOD) + (size_t)l * 9 * 6 * D;
    for (int i = tid; i < 9 * 64; i += 512) { const int r = i >> 6, cc = i & 63; float s = a->in[5][(size_t)l * 6 * D + n0 + cc];
#pragma unroll
        for (int q = 0; q < 8; ++q) s += red[(q * 9 + r) * 64 + cc];
        mod[(size_t)r * 6 * D + n0 + cc] = s; }
    __syncthreads();
}

DI void unpack8(const u32x4& w, float* o) { o[0] = bflo(w.x); o[1] = bfhi(w.x); o[2] = bflo(w.y); o[3] = bfhi(w.y); o[4] = bflo(w.z); o[5] = bfhi(w.z); o[6] = bflo(w.w); o[7] = bfhi(w.w); }
DI u32x4 packv8(const float* o) { u32x4 w; w.x = pk2(o[0], o[1]); w.y = pk2(o[2], o[3]); w.z = pk2(o[4], o[5]); w.w = pk2(o[6], o[7]); return w; }
DI void ctx_fixup(float* xc, const float* parts, const float* pgate, int row0, int nrows) {
    int tx_ = threadIdx.x; asm volatile("" : "+v"(tx_));
    const int lane = tx_ & 63, gw = blockIdx.x * 8 + (tx_ >> 6), nw = gridDim.x * 8;
    for (int r = row0 + gw; r < row0 + nrows; r += nw) {
#pragma unroll
        for (int i = 0; i < 4; ++i) { const int c = lane * 4 + 256 * i; f32x4 sm = *(const f32x4*)(parts + (size_t)r * D + c);
#pragma unroll
            for (int ks = 1; ks < 8; ++ks) sm += *(const f32x4*)(parts + (size_t)ks * M_CTX * D + (size_t)r * D + c);
            *(f32x4*)(xc + (size_t)r * D + c) = *(const f32x4*)(xc + (size_t)r * D + c) + *(const f32x4*)(pgate + c) * sm; }
    }
}
DI void norm_phase(const float* src_lat, const float* src_ctx, int nlat, int ntot, int latoff, int ctxoff,
                   const float* __restrict__ gnorm, const float* __restrict__ modl, int shoff, int scoff, bf16_t* dst) {
    int tx_ = threadIdx.x; asm volatile("" : "+v"(tx_));
    const int lane = tx_ & 63, gw = blockIdx.x * 8 + (tx_ >> 6), nw = gridDim.x * 8;
    for (int r = gw; r < ntot; r += nw) {
        const bool lat = r < nlat;
        const float* x = lat ? src_lat + (size_t)(latoff + r) * D : src_ctx + (size_t)(ctxoff + r - nlat) * D;
        const int b = lat ? (latoff + r) / SEQ : NBATCH;
        const float* mb = modl + (size_t)b * 6 * D;
        f32x4 v[4], g[4], sc[4], sh[4]; float ss = 0.f;
#pragma unroll
        for (int i = 0; i < 4; ++i) { const int c = lane * 4 + 256 * i; v[i] = ntload((const f32x4*)(x + c)); g[i] = *(const f32x4*)(gnorm + c); sc[i] = *(const f32x4*)(mb + scoff + c); sh[i] = *(const f32x4*)(mb + shoff + c); }
#pragma unroll
        for (int i = 0; i < 4; ++i) ss += v[i][0] * v[i][0] + v[i][1] * v[i][1] + v[i][2] * v[i][2] + v[i][3] * v[i][3];
        ss = wave_sum(ss);
        const float rstd = rsqrtf(ss * (1.f / D) + EPS);
#pragma unroll
        for (int i = 0; i < 4; ++i) { const int c = lane * 4 + 256 * i;
            f32x4 y;
#pragma unroll
            for (int j = 0; j < 4; ++j) y[j] = (v[i][j] * rstd * g[i][j]) * (1.f + sc[i][j]) + sh[i][j];
            u32x2 w; w.x = pk2(y[0], y[1]); w.y = pk2(y[2], y[3]);
            *(u32x2*)(dst + (size_t)r * D + c) = w; }
    }
}

DI void prep_phase(KArgs a, int l, bool want_ctx, bf16_t* P, const bf16_t* T, bf16_t* Qb, bf16_t* Qc, bf16_t* Kb, bf16_t* Vb, const float* ropetab) {
    int tx_ = threadIdx.x; asm volatile("" : "+v"(tx_));
    const int lane = tx_ & 63, gw = blockIdx.x * 8 + (tx_ >> 6), nw = gridDim.x * 8;
    const int hd = lane >> 3, k = lane & 7;
    const float* gq = a->in[17] + l * 96; const float* gk = a->in[18] + l * 96;
    float gqn[8], gqr[4], gkn[8], gkr[4], nqw[16];
#pragma unroll
    for (int i = 0; i < 8; ++i) { gqn[i] = gq[8 * k + i]; gkn[i] = gk[8 * k + i]; }
#pragma unroll
    for (int i = 0; i < 4; ++i) { gqr[i] = gq[64 + 4 * k + i]; gkr[i] = gk[64 + 4 * k + i]; }
    const float QS = 0.10206207261596577f * LOG2E, NAS = 0.125f * LOG2E;
    { const float* nw_ = (lane < 32) ? a->in[20] + l * 64 : a->in[21] + l * 64; const float sc_ = (lane < 32) ? NAS : 1.f;
#pragma unroll
      for (int i = 0; i < 16; ++i) nqw[i] = nw_[16 * (lane & 3) + i] * sc_; }
    const int sec = k >> 2, second = (k >> 1) & 1;
    for (int r = gw; r < MG; r += nw) {
        const bool lat = r < MG_LAT;
        int bl, tt, tall;
        if (lat) { bl = r / SEQ; tt = r % SEQ; tall = CTXL + tt; } else { const int rc = r - MG_LAT; bl = rc / CTXL; tt = rc % CTXL; tall = tt; }
        const bool need_q = lat || want_ctx;
        bf16_t* Pr = P + (size_t)r * NP; const bf16_t* Tr = T + (size_t)r * TW;
        const u32x4 d0 = ntload((const u32x4*)(Pr + PC_DQ + 8 * lane));
        u32x4 d1 = (u32x4){0u, 0u, 0u, 0u}; if (lane < 16) d1 = *(const u32x4*)(Pr + PC_DQ + 512 + 8 * lane);
        const u32x2 krw = *(const u32x2*)(Pr + PC_KR + 4 * k);
        const u32x4 tqn = ntload((const u32x4*)(Tr + hd * 96 + 8 * k)); const u32x2 tqr = ntload((const u32x2*)(Tr + hd * 96 + 64 + 4 * k));
        const u32x4 tkn = ntload((const u32x4*)(Tr + 768 + hd * 128 + 8 * k)), tv = ntload((const u32x4*)(Tr + 768 + hd * 128 + 64 + 8 * k));
        u32x4 na0 = *(const u32x4*)(Pr + PC_NAQ + 16 * lane), na1 = *(const u32x4*)(Pr + PC_NAQ + 16 * lane + 8);
        f32x4 rt0 = (f32x4){1.f, 0.f, 1.f, 0.f}, rt1 = rt0;
        if (lat) { const int pos = sec ? (tt & 63) : (tt >> 6); const float* rp = ropetab + (size_t)(pos * 8 + 4 * (k & 1)) * 2; rt0 = *(const f32x4*)rp; rt1 = *(const f32x4*)(rp + 4); }
        float e0[8], e1[8]; unpack8(d0, e0); unpack8(d1, e1);
        float s0 = 0.f, s1 = 0.f;
#pragma unroll
        for (int i = 0; i < 8; ++i) { s0 += e0[i] * e0[i]; s1 += e1[i] * e1[i]; }
        const float ssq = wave_sum(lane < 48 ? s0 : 0.f), skv = wave_sum((lane < 48 ? 0.f : s0) + s1);
        const float rstd_q = rsqrtf(ssq * (1.f / 384.f) + EPS), rstd_kv = rsqrtf(skv * (1.f / 256.f) + EPS);
        const float cs4[4] = {rt0[0], rt0[2], rt1[0], rt1[2]}, sn4[4] = {rt0[1], rt0[3], rt1[1], rt1[3]};
        if (need_q) {
            float xn[8], xr[4]; unpack8(tqn, xn); xr[0] = bflo(tqr.x); xr[1] = bfhi(tqr.x); xr[2] = bflo(tqr.y); xr[3] = bfhi(tqr.y);
            float ss = 0.f;
#pragma unroll
            for (int i = 0; i < 8; ++i) { xn[i] *= rstd_q; ss += xn[i] * xn[i]; }
#pragma unroll
            for (int i = 0; i < 4; ++i) { xr[i] *= rstd_q; ss += xr[i] * xr[i]; }
            const float rs = rsqrtf(sum8(ss) * (1.f / 96.f) + EPS) ;
#pragma unroll
            for (int i = 0; i < 8; ++i) xn[i] = xn[i] * rs * gqn[i] * QS;
#pragma unroll
            for (int i = 0; i < 4; ++i) { const float y = xr[i] * rs * gqr[i]; const float xp = dpp_f<0x4E>(y); xr[i] = (second ? y * cs4[i] + xp * sn4[i] : y * cs4[i] - xp * sn4[i]) * QS; }
            bf16_t* dst = lat ? Qb + ((size_t)(bl * 8 + hd) * SEQ + tt) * 96 : Qc + ((size_t)(bl * 8 + hd) * CTXL + tt) * 96;
            *(u32x4*)(dst + 8 * k) = packv8(xn); u32x2 w; w.x = pk2(xr[0], xr[1]); w.y = pk2(xr[2], xr[3]); *(u32x2*)(dst + 64 + 4 * k) = w;
        }
        {
            float xn[8], xr[4], vv[8]; unpack8(tkn, xn); unpack8(tv, vv); xr[0] = bflo(krw.x); xr[1] = bfhi(krw.x); xr[2] = bflo(krw.y); xr[3] = bfhi(krw.y);
            float ss = 0.f;
#pragma unroll
            for (int i = 0; i < 8; ++i) { xn[i] *= rstd_kv; vv[i] *= rstd_kv; ss += xn[i] * xn[i]; }
#pragma unroll
            for (int i = 0; i < 4; ++i) ss += xr[i] * xr[i];
            const float rs = rsqrtf(sum8(ss) * (1.f / 96.f) + EPS);
#pragma unroll
            for (int i = 0; i < 8; ++i) xn[i] = xn[i] * rs * gkn[i];
#pragma unroll
            for (int i = 0; i < 4; ++i) { const float y = xr[i] * rs * gkr[i]; const float xp = dpp_f<0x4E>(y); xr[i] = second ? y * cs4[i] + xp * sn4[i] : y * cs4[i] - xp * sn4[i]; }
            bf16_t* dst = Kb + ((size_t)(bl * 8 + hd) * TALL + tall) * 96;
            *(u32x4*)(dst + 8 * k) = packv8(xn); u32x2 w; w.x = pk2(xr[0], xr[1]); w.y = pk2(xr[2], xr[3]); *(u32x2*)(dst + 64 + 4 * k) = w;
            *(u32x4*)(Vb + ((size_t)(bl * 8 + hd) * TALL + tall) * 64 + 8 * k) = packv8(vv);
        }
        {
            float x0[8], x1[8]; unpack8(na0, x0); unpack8(na1, x1);
            float ss = 0.f;
#pragma unroll
            for (int i = 0; i < 8; ++i) ss += x0[i] * x0[i] + x1[i] * x1[i];
            const float rs = rsqrtf(sum4(ss) * (1.f / 64.f) + EPS);
#pragma unroll
            for (int i = 0; i < 8; ++i) { x0[i] = x0[i] * rs * nqw[i]; x1[i] = x1[i] * rs * nqw[8 + i]; }
            *(u32x4*)(Pr + PC_NAQ + 16 * lane) = packv8(x0); *(u32x4*)(Pr + PC_NAQ + 16 * lane + 8) = packv8(x1);
        }
    }
}

DI void mlcomb_phase(KArgs a, int l, int nrows, bf16_t* P, const bf16_t* HD0, const bf16_t* HD1) {
    int tx_ = threadIdx.x; asm volatile("" : "+v"(tx_));
    const int lane = tx_ & 63, gw = blockIdx.x * 8 + (tx_ >> 6), nw = gridDim.x * 8;
    const float* gout = a->in[11] + l * 512 + 8 * lane;
    float go[8];
#pragma unroll
    for (int i = 0; i < 8; ++i) go[i] = gout[i];
    for (int r = gw; r < nrows; r += nw) {
        bf16_t* Pr = P + (size_t)r * NP + PC_MLO + 8 * lane;
        const u32x4 w0 = ntload((const u32x4*)(HD0 + (size_t)r * 512 + 8 * lane)), w1 = ntload((const u32x4*)(HD1 + (size_t)r * 512 + 8 * lane)), wo = *(const u32x4*)Pr;
        float h0[8], h1[8], o[8]; unpack8(w0, h0); unpack8(w1, h1); unpack8(wo, o);
        float ss = 0.f;
#pragma unroll
        for (int i = 0; i < 8; ++i) { h0[i] += h1[i]; ss += h0[i] * h0[i]; }
        const float rs = rsqrtf(sum16(ss) * (1.f / 128.f) + EPS);
#pragma unroll
        for (int i = 0; i < 8; ++i) h0[i] = h0[i] * rs * go[i] * sigmoidf_(o[i]);
        *(u32x4*)Pr = packv8(h0);
    }
}

DI float max3f(float a, float b, float c) { float r; asm("v_max3_f32 %0, %1, %2, %3" : "=v"(r) : "v"(a), "v"(b), "v"(c)); return r; }
DI float max2f(float a, float b) { float r; asm("v_max_f32_e32 %0, %1, %2" : "=v"(r) : "v"(a), "v"(b)); return r; }
typedef short s16x4 __attribute__((ext_vector_type(4)));
DI s16x4 vtr(const LAS char* p) { return __builtin_bit_cast(s16x4, __builtin_amdgcn_ds_read_tr16_b64_v4i16((LAS s16x4*)p)); }
DI int crow(int reg, int h) { return (reg & 3) + 8 * (reg >> 2) + 4 * h; }
#define MFMA32(a, b, c) __builtin_amdgcn_mfma_f32_32x32x16_bf16((a), (b), (c), 0, 0, 0)
DI bf16x8 pack8(const f32x16& x, int s) {
    u32x4 p; p.x = pk2(x[8 * s], x[8 * s + 1]); p.y = pk2(x[8 * s + 2], x[8 * s + 3]); p.z = pk2(x[8 * s + 4], x[8 * s + 5]); p.w = pk2(x[8 * s + 6], x[8 * s + 7]);
    return __builtin_bit_cast(bf16x8, p);
}
struct AttnP {
    const bf16_t* Q; int q_ld;
    const bf16_t* Kb; const bf16_t* Vb;
    const bf16_t* Kc; const bf16_t* Vc;
    bf16_t* O; int o_ld;
    int ntiles, nb, rlo, r0;
    const float* rpb;
    int fix;
    float C;
};
template <int MODE, bool FIX>
DI void attn_unit(char* lds, const AttnP& p) {
    constexpr int DQK = MODE == 0 ? 96 : 64, NST = DQK / 16, NCH = DQK / 8, KSTRB = (DQK + 8) * 2, VSTRB = 144, KBUF = 13312, VBUF = 9216;
    char* Kb0 = lds; char* Vb0 = lds + 2 * KBUF; float* rpbL = (float*)(lds + 2 * KBUF + 2 * VBUF);
    int tid = threadIdx.x; asm volatile("" : "+v"(tid));
    const int w = tid >> 6, lane = tid & 63, r = lane & 31, h = lane >> 5;
    const int nt = p.ntiles;
    bf16x8 qf[NST];
    { const bf16_t* qp = p.Q + (size_t)(32 * w + r) * p.q_ld + 8 * h;
#pragma unroll
      for (int st = 0; st < NST; ++st) qf[st] = *(const bf16x8*)(qp + 16 * st); }
    f32x16 o0, o1, p0, p1, n0, n1;
#pragma unroll
    for (int i = 0; i < 16; ++i) { o0[i] = 0.f; o1[i] = 0.f; p0[i] = 0.f; p1[i] = 0.f; n0[i] = 0.f; n1[i] = 0.f; }
    float m_run = -1e30f, l_run = 0.f;
    const float sinit = FIX ? -p.C : 0.f;
    const int rq = p.r0 + (w >> 1), rs = min(max(rq - 4, 0), 56), qc = 32 * (w & 1) + r, cs = min(max(qc - 8, 0), 48);
    unsigned idxp0[4], idxp1[4];
    if (MODE == 1) {
        for (int i = tid; i < 480; i += 512) { const int dr = i >> 5, d = i & 31; rpbL[i] = (d < 31) ? p.rpb[dr * 31 + d] * LOG2E : -1e30f; }
#pragma unroll
        for (int k4 = 0; k4 < 4; ++k4) { unsigned a0 = 0u, a1 = 0u;
#pragma unroll
            for (int m = 0; m < 4; ++m) { const int i = 4 * k4 + m; const int c0 = crow(i, h), c1 = 32 + c0;
                a0 |= (unsigned)((((unsigned)(c0 - cs) < 16u) ? (c0 - qc + 15) : 31) * 4) << (8 * m);
                a1 |= (unsigned)((((unsigned)(c1 - cs) < 16u) ? (c1 - qc + 15) : 31) * 4) << (8 * m); }
            idxp0[k4] = a0; idxp1[k4] = a1; }
    }
    const int krow0 = tid / NCH, kch0 = tid % NCH, krow1 = (tid + 512) / NCH, kch1 = (tid + 512) % NCH;
    const bool k2 = (MODE == 0) && (tid < 256);
    const int vkey = tid >> 3, vdg = tid & 7;
    u32x4 kr0, kr1 = (u32x4){0u, 0u, 0u, 0u}, vr, kx0 = (u32x4){0u, 0u, 0u, 0u}, kx1 = (u32x4){0u, 0u, 0u, 0u}, vx = (u32x4){0u, 0u, 0u, 0u};
#define ATT_KV(j) const bf16_t* kp; const bf16_t* vp; size_t kld, vld; \
        if (MODE == 0) { kp = p.Kb + (size_t)(j) * 64 * 96; vp = p.Vb + (size_t)(j) * 64 * 64; kld = 96; vld = 64; } \
        else if ((j) < p.nb) { kp = p.Kb + (size_t)(p.rlo + (j)) * 64 * NP; vp = p.Vb + (size_t)(p.rlo + (j)) * 64 * NP; kld = NP; vld = NP; } \
        else { kp = p.Kc + (size_t)((j) - p.nb) * 64 * NP; vp = p.Vc + (size_t)((j) - p.nb) * 64 * NP; kld = NP; vld = NP; }
#define ATT_LOADK(j) do { ATT_KV(j); (void)vp; (void)vld; kr0 = *(const u32x4*)(kp + (size_t)krow0 * kld + kch0 * 8); if (k2) kr1 = *(const u32x4*)(kp + (size_t)krow1 * kld + kch1 * 8); } while (0)
#define ATT_LOADV(j) do { ATT_KV(j); (void)kp; (void)kld; vr = *(const u32x4*)(vp + (size_t)vkey * vld + vdg * 8); } while (0)
#define ATT_LOADKX(j) do { ATT_KV(j); (void)vp; (void)vld; kx0 = *(const u32x4*)(kp + (size_t)krow0 * kld + kch0 * 8); if (k2) kx1 = *(const u32x4*)(kp + (size_t)krow1 * kld + kch1 * 8); } while (0)
#define ATT_LOADVX(j) do { ATT_KV(j); (void)kp; (void)kld; vx = *(const u32x4*)(vp + (size_t)vkey * vld + vdg * 8); } while (0)
#define ATT_STOREK(b) do { char* Ks_ = Kb0 + (b) * KBUF; *(u32x4*)(Ks_ + krow0 * KSTRB + kch0 * 16) = kr0; if (k2) *(u32x4*)(Ks_ + krow1 * KSTRB + kch1 * 16) = kr1; } while (0)
#define ATT_STOREV(b) do { *(u32x4*)(Vb0 + (b) * VBUF + vkey * VSTRB + vdg * 16) = vr; } while (0)
#define ATT_QK(S0, S1, b) do { const char* Ks_ = Kb0 + (b) * KBUF + r * KSTRB + 16 * h; \
        _Pragma("unroll") for (int i_ = 0; i_ < 16; ++i_) { S0[i_] = sinit; S1[i_] = sinit; } \
        _Pragma("unroll") for (int st = 0; st < NST; ++st) { const bf16x8 a0 = *(const bf16x8*)(Ks_ + 32 * st), a1 = *(const bf16x8*)(Ks_ + 32 * KSTRB + 32 * st); \
            S0 = MFMA32(a0, qf[st], S0); S1 = MFMA32(a1, qf[st], S1); } } while (0)
#define ATT_ACT(j) (!((MODE == 1) && ((j) < p.nb) && !((p.rlo + (j)) >= rs && (p.rlo + (j)) < rs + 8)))
    ATT_LOADK(0); ATT_LOADV(0); ATT_STOREK(0); ATT_STOREV(0);
    if (nt > 1) { ATT_LOADK(1); ATT_STOREK(1); }
    if (nt > 2) ATT_LOADK(2);
    if (nt > 1) ATT_LOADV(1);
    __syncthreads();
    if (ATT_ACT(0)) ATT_QK(p0, p1, 0);
    __syncthreads();
    int j = 0;
#pragma unroll
    for (int ph = 0; ph < 2; ++ph) {
    const bool FULL = (ph == 0);
    const int jend = FULL ? nt - 3 : nt;
    for (; j < jend; ++j) {
        if (FULL || j + 2 < nt) ATT_STOREK(j & 1);
        if (FULL || j + 1 < nt) ATT_STOREV((j + 1) & 1);
        if (FULL || j + 3 < nt) ATT_LOADK(j + 3);
        if (FULL || j + 2 < nt) ATT_LOADV(j + 2);
        if (MODE == 0) { ATT_QK(n0, n1, (j + 1) & 1); }
        else if (j + 1 < nt && ATT_ACT(j + 1)) { ATT_QK(n0, n1, (j + 1) & 1); }
        if (ATT_ACT(j)) {
            if ((MODE == 1) && (j < p.nb)) {
                const char* browb = (const char*)(rpbL + (p.rlo + j - rq + 7) * 32);
#pragma unroll
                for (int i = 0; i < 16; ++i) { p0[i] += *(const float*)(browb + ((idxp0[i >> 2] >> (8 * (i & 3))) & 0xffu)); p1[i] += *(const float*)(browb + ((idxp1[i >> 2] >> (8 * (i & 3))) & 0xffu)); }
            }
            if (FIX) {
#pragma unroll
                for (int i = 0; i < 16; ++i) { p0[i] = __builtin_amdgcn_exp2f(p0[i]); p1[i] = __builtin_amdgcn_exp2f(p1[i]); }
                const f32x16 ps = p0 + p1;
                l_run += ((ps[0] + ps[1]) + (ps[2] + ps[3])) + ((ps[4] + ps[5]) + (ps[6] + ps[7])) + ((ps[8] + ps[9]) + (ps[10] + ps[11])) + ((ps[12] + ps[13]) + (ps[14] + ps[15]));
            } else {
            float tmax = max2f(p0[0], p1[0]), tmax2 = max2f(p0[1], p1[1]);
#pragma unroll
            for (int i = 2; i < 16; i += 2) { tmax = max3f(tmax, p0[i], p1[i]); tmax2 = max3f(tmax2, p0[i + 1], p1[i + 1]); }
            tmax = max2f(tmax, tmax2);
            tmax = max2f(tmax, shx(tmax, lane, 32));
            const float m_new = max2f(m_run, tmax), alpha = __builtin_amdgcn_exp2f(m_run - m_new);
            p0 = p0 - m_new; p1 = p1 - m_new;
#pragma unroll
            for (int i = 0; i < 16; ++i) { p0[i] = __builtin_amdgcn_exp2f(p0[i]); p1[i] = __builtin_amdgcn_exp2f(p1[i]); }
            const f32x16 ps = p0 + p1;
            float rsum = ((ps[0] + ps[1]) + (ps[2] + ps[3])) + ((ps[4] + ps[5]) + (ps[6] + ps[7])) + ((ps[8] + ps[9]) + (ps[10] + ps[11])) + ((ps[12] + ps[13]) + (ps[14] + ps[15]));
            rsum += shx(rsum, lane, 32);
            l_run = l_run * alpha + rsum; m_run = m_new;
            o0 = o0 * alpha; o1 = o1 * alpha;
            }
            const LAS char* vbase = (const LAS char*)(Vb0 + (j & 1) * VBUF) + (4 * h + ((lane & 15) >> 2)) * VSTRB + ((lane >> 4) & 1) * 32 + (lane & 3) * 8;
#pragma unroll
            for (int kb = 0; kb < 2; ++kb)
#pragma unroll
                for (int s = 0; s < 2; ++s) {
                    const bf16x8 pf = pack8(kb ? p1 : p0, s);
                    const LAS char* vb = vbase + (32 * kb + 16 * s) * VSTRB;
                    const s16x4 l0 = vtr(vb), h0 = vtr(vb + 8 * VSTRB), l1 = vtr(vb + 64), h1 = vtr(vb + 8 * VSTRB + 64);
                    const bf16x8 v0 = __builtin_shufflevector(l0, h0, 0, 1, 2, 3, 4, 5, 6, 7), v1 = __builtin_shufflevector(l1, h1, 0, 1, 2, 3, 4, 5, 6, 7);
                    o0 = MFMA32(v0, pf, o0); o1 = MFMA32(v1, pf, o1);
                }
        }
        __syncthreads();
        p0 = n0; p1 = n1;
    }
    }
#undef ATT_KV
#undef ATT_LOADK
#undef ATT_LOADV
#undef ATT_LOADKX
#undef ATT_LOADVX
#undef ATT_STOREK
#undef ATT_STOREV
#undef ATT_QK
#undef ATT_ACT
    if (FIX) l_run += shx(l_run, lane, 32);
    const float inv = 1.f / l_run;
    bf16_t* op = p.O + (size_t)(32 * w + r) * p.o_ld + 4 * h;
#pragma unroll
    for (int i4 = 0; i4 < 4; ++i4) {
        u32x2 w0, w1; w0.x = pk2(o0[4 * i4] * inv, o0[4 * i4 + 1] * inv); w0.y = pk2(o0[4 * i4 + 2] * inv, o0[4 * i4 + 3] * inv);
        w1.x = pk2(o1[4 * i4] * inv, o1[4 * i4 + 1] * inv); w1.y = pk2(o1[4 * i4 + 2] * inv, o1[4 * i4 + 3] * inv);
        *(u32x2*)(op + 8 * i4) = w0; *(u32x2*)(op + 32 + 8 * i4) = w1;
    }
}

#define ML_ROW(ci, t) (((ci) < 4) ? (MG_LAT + bl * CTXL + (dir ? (3 - (ci)) * 64 + 63 - (t) : (ci) * 64 + (t))) : (bl * SEQ + (dir ? (67 - (ci)) * 64 + 63 - (t) : ((ci) - 4) * 64 + (t))))
constexpr int ML_NSEQ = 32, ML_NCH = 68, ML_ITEMS = ML_NSEQ * ML_NCH;
constexpr size_t WS_DC = WS_H, WS_CS = 475 * MiB, WS_SM = 509 * MiB, SM_DN = 0, SM_NST = 0x90000, SM_SCAL = 0x120000, SM_MST = 0x128000, SM_TAB = 0x130000;
DI void mlA_phase(char* lds, KArgs a, int l, const bf16_t* P, unsigned char* ws) {
    constexpr int STR = 144;
    char* KTs = lds + 18432; char* VTs = lds + 27648;
    float* tab = (float*)(lds + 64512); float* tu = tab; float* misc = tab + 384;
    int tid = threadIdx.x; asm volatile("" : "+v"(tid));
    const int w = tid >> 6, lane = tid & 63, r = lane & 31, h = lane >> 5, eb = w >> 1, xb = w & 1;
    const int srow = tid >> 3, sch = tid & 7;
    const int G = gridDim.x;
    u32x4 rk, rv0, rv1; float gi = 0.f, gf = 0.f;
#define MLA_LOAD(item) do { const int sq_ = (item) / ML_NCH, ci_ = (item) % ML_NCH, dir = sq_ & 1, hh_ = (sq_ >> 1) & 3, bl = sq_ >> 3; \
        const bf16_t* pr = P + (size_t)ML_ROW(ci_, srow) * NP; \
        rk = *(const u32x4*)(pr + PC_MLK + hh_ * 64 + sch * 8); rv0 = *(const u32x4*)(pr + PC_MLV + hh_ * 128 + sch * 8); rv1 = *(const u32x4*)(pr + PC_MLV + hh_ * 128 + 64 + sch * 8); \
        if (w == 0) { const bf16_t* pg = P + (size_t)ML_ROW(ci_, lane) * NP + PC_GT; gi = bf2f(pg[(2 * dir) * 4 + hh_]); gf = bf2f(pg[(2 * dir + 1) * 4 + hh_]); } } while (0)
    int item = blockIdx.x;
    if (item < ML_ITEMS) MLA_LOAD(item);
    for (; item < ML_ITEMS; item += G) {
        const int sq = item / ML_NCH, dir = sq & 1, hh = (sq >> 1) & 3;
        if (w == 0) {
            const float ib = a->in[9][(l * 2 + dir) * 4 + hh], fb = a->in[10][(l * 2 + dir) * 4 + hh];
            const float x = gf + fb;
            const float lf = fminf(x, 0.f) - log1pf(expf(-fabsf(x)));
            float bc = lf;
#pragma unroll
            for (int o = 1; o < 64; o <<= 1) { const float v = shu(bc, lane, o); if (lane >= o) bc += v; }
            const float u = gi + ib - bc;
            float am = u;
#pragma unroll
            for (int o = 1; o < 64; o <<= 1) { const float v = shu(am, lane, o); if (lane >= o) am = fmaxf(am, v); }
            { float* tb = (float*)(ws + WS_SM + SM_TAB) + (size_t)item * 192; tb[lane] = u; tb[64 + lane] = bc; tb[128 + lane] = am; }
            tu[lane] = u;
            const float btot = rdl63(bc); am = rdl63(am);
            if (lane == 0) { misc[1] = am; float* sc = (float*)(ws + WS_SM + SM_SCAL) + (size_t)item * 2; sc[0] = btot; sc[1] = am; }
        }
        { const unsigned vw[8] = {rv0.x, rv0.y, rv0.z, rv0.w, rv1.x, rv1.y, rv1.z, rv1.w};
#pragma unroll
          for (int i = 0; i < 8; ++i) { const int e = (i < 4 ? 0 : 64) + sch * 8 + 2 * (i & 3);
              *(bf16_t*)(VTs + e * STR + srow * 2) = (bf16_t)(vw[i] & 0xffffu); *(bf16_t*)(VTs + (e + 1) * STR + srow * 2) = (bf16_t)(vw[i] >> 16); } }
        __syncthreads();
        { const float wk = __expf(tu[srow] - misc[1]);
          const unsigned kw[4] = {rk.x, rk.y, rk.z, rk.w};
#pragma unroll
          for (int i = 0; i < 4; ++i) { *(bf16_t*)(KTs + (sch * 8 + 2 * i) * STR + srow * 2) = f2bf(bflo(kw[i]) * wk); *(bf16_t*)(KTs + (sch * 8 + 2 * i + 1) * STR + srow * 2) = f2bf(bfhi(kw[i]) * wk); } }
        if (item + G < ML_ITEMS) MLA_LOAD(item + G);
        __syncthreads();
        {
            f32x16 C;
#pragma unroll
            for (int i = 0; i < 16; ++i) C[i] = 0.f;
#pragma unroll
            for (int st = 0; st < 4; ++st) {
                const bf16x8 vA = *(const bf16x8*)(VTs + (32 * eb + r) * STR + (16 * st + 8 * h) * 2), kB = *(const bf16x8*)(KTs + (32 * xb + r) * STR + (16 * st + 8 * h) * 2);
                C = MFMA32(vA, kB, C);
            }
            bf16_t* dc = (bf16_t*)(ws + WS_DC) + (size_t)item * 8192;
#pragma unroll
            for (int i = 0; i < 16; ++i) dc[(32 * eb + crow(i, h)) * 64 + 32 * xb + r] = f2bf(C[i]);
            const u32x4 kk = *(const u32x4*)(KTs + srow * STR + sch * 16);
            float sm = bflo(kk.x) + bfhi(kk.x) + bflo(kk.y) + bfhi(kk.y) + bflo(kk.z) + bfhi(kk.z) + bflo(kk.w) + bfhi(kk.w);
            sm += shx(sm, lane, 1); sm += shx(sm, lane, 2); sm += shx(sm, lane, 4);
            if (sch == 0) ((float*)(ws + WS_SM + SM_DN))[(size_t)item * 64 + srow] = sm;
        }
        __syncthreads();
    }
#undef MLA_LOAD
}
DI void mlB_phase(char* lds, unsigned char* ws) {
    int tx_ = threadIdx.x; asm volatile("" : "+v"(tx_));
    const int gt = blockIdx.x * 512 + tx_;
    const int sq = (blockIdx.x * 512) >> 12, pi = gt & 4095;
    float* sA = (float*)lds; float* sB = sA + 80; float* sM = sA + 160; float* sBt = sA + 240; float* sMl = sA + 320;
    if (sq >= ML_NSEQ) return;
    if (tx_ < ML_NCH) { const float* sc = (const float*)(ws + WS_SM + SM_SCAL) + ((size_t)sq * ML_NCH + tx_) * 2; sBt[tx_] = sc[0]; sMl[tx_] = sc[1]; }
    __syncthreads();
    if (tx_ == 0) { float m = 0.f;
        for (int ci = 0; ci < ML_NCH; ++ci) { const float M = fmaxf(m, sMl[ci]); sA[ci] = __expf(m - M); sB[ci] = __expf(sMl[ci] - M); sM[ci] = m; m = sBt[ci] + M; } }
    __syncthreads();
    const unsigned* __restrict__ dc = (const unsigned*)(ws + WS_DC) + (size_t)sq * ML_NCH * 4096 + pi;
    unsigned* __restrict__ cs = (unsigned*)(ws + WS_CS) + (size_t)sq * ML_NCH * 4096 + pi;
    const float* __restrict__ dn = (const float*)(ws + WS_SM + SM_DN) + (size_t)sq * ML_NCH * 64 + pi;
    float* __restrict__ nst = (float*)(ws + WS_SM + SM_NST) + (size_t)sq * ML_NCH * 64 + pi;
    float* __restrict__ mst = (float*)(ws + WS_SM + SM_MST) + (size_t)sq * ML_NCH;
    float c0 = 0.f, c1 = 0.f, n = 0.f;
    for (int cb = 0; cb < ML_NCH; cb += 17) {
        unsigned dv[17]; float dnv[17];
#pragma unroll
        for (int q = 0; q < 17; ++q) { dv[q] = dc[(size_t)(cb + q) * 4096]; dnv[q] = (pi < 64) ? dn[(size_t)(cb + q) * 64] : 0.f; }
#pragma unroll
        for (int q = 0; q < 17; ++q) {
            const int ci = cb + q;
            cs[(size_t)ci * 4096] = pk2(c0, c1);
            if (pi < 64) nst[(size_t)ci * 64] = n;
            if (pi == 0) mst[ci] = sM[ci];
            const float aa = sA[ci], bb = sB[ci];
            c0 = aa * c0 + bb * bflo(dv[q]); c1 = aa * c1 + bb * bfhi(dv[q]); n = aa * n + bb * dnv[q];
        }
    }
    __syncthreads();
}
DI void mlC_phase(char* lds, const bf16_t* P, unsigned char* ws, bf16_t* HD0, bf16_t* HD1) {
    constexpr int STR = 144;
    char* Qs = lds; char* Ks = lds + 9216; char* VTs = lds + 27648; char* CTs = lds + 46080;
    float* tab = (float*)(lds + 64512); float* tu = tab; float* tM = tab + 64; float* tbc = tab + 128; float* tain = tab + 192; float* qn = tab + 320;
    int tid = threadIdx.x; asm volatile("" : "+v"(tid));
    const int w = tid >> 6, lane = tid & 63, r = lane & 31, h = lane >> 5, eb = w >> 1, xb = w & 1;
    const int srow = tid >> 3, sch = tid & 7, G = gridDim.x;
    u32x4 rq, rk, rv0, rv1, cs0, cs1; f32x4 n0, n1; float m_state = 0.f, gu = 0.f, gbc = 0.f, gam = 0.f;
#define MLC_LOAD(item) do { const int sq_ = (item) / ML_NCH, ci_ = (item) % ML_NCH, dir = sq_ & 1, hh_ = (sq_ >> 1) & 3, bl = sq_ >> 3; \
        const bf16_t* pr = P + (size_t)ML_ROW(ci_, srow) * NP; \
        rq = *(const u32x4*)(pr + PC_MLQ + hh_ * 64 + sch * 8); rk = *(const u32x4*)(pr + PC_MLK + hh_ * 64 + sch * 8); \
        rv0 = *(const u32x4*)(pr + PC_MLV + hh_ * 128 + sch * 8); rv1 = *(const u32x4*)(pr + PC_MLV + hh_ * 128 + 64 + sch * 8); \
        const u32x4* csp = (const u32x4*)((const bf16_t*)(ws + WS_CS) + (size_t)(item) * 8192); cs0 = csp[tid]; cs1 = csp[tid + 512]; \
        const float* nstp = (const float*)(ws + WS_SM + SM_NST) + (size_t)(item) * 64 + sch * 8; n0 = *(const f32x4*)nstp; n1 = *(const f32x4*)(nstp + 4); \
        m_state = ((const float*)(ws + WS_SM + SM_MST))[item]; \
        if (w == 0) { const float* tb = (const float*)(ws + WS_SM + SM_TAB) + (size_t)(item) * 192; gu = tb[lane]; gbc = tb[64 + lane]; gam = tb[128 + lane]; } } while (0)
    int item = blockIdx.x;
    if (item < ML_ITEMS) MLC_LOAD(item);
    for (; item < ML_ITEMS; item += G) {
        const int sq = item / ML_NCH, ci = item % ML_NCH, dir = sq & 1, hh = (sq >> 1) & 3, bl = sq >> 3;
        bf16_t* HD = dir ? HD1 : HD0;
        if (w == 0) { const float Mt = fmaxf(m_state, gam); tu[lane] = gu; tM[lane] = Mt; tbc[lane] = gbc; tain[lane] = __expf(m_state - Mt); }
        float qv[8];
        { const unsigned qw[4] = {rq.x, rq.y, rq.z, rq.w};
#pragma unroll
          for (int i = 0; i < 4; ++i) { qv[2 * i] = bflo(qw[i]) * 0.125f; qv[2 * i + 1] = bfhi(qw[i]) * 0.125f; } }
        { u32x4 qs; qs.x = pk2(qv[0], qv[1]); qs.y = pk2(qv[2], qv[3]); qs.z = pk2(qv[4], qv[5]); qs.w = pk2(qv[6], qv[7]);
          *(u32x4*)(Qs + srow * STR + sch * 16) = qs; *(u32x4*)(Ks + srow * STR + sch * 16) = rk; }
        { const unsigned vw[8] = {rv0.x, rv0.y, rv0.z, rv0.w, rv1.x, rv1.y, rv1.z, rv1.w};
#pragma unroll
          for (int i = 0; i < 8; ++i) { const int e = (i < 4 ? 0 : 64) + sch * 8 + 2 * (i & 3);
              *(bf16_t*)(VTs + e * STR + srow * 2) = (bf16_t)(vw[i] & 0xffffu); *(bf16_t*)(VTs + (e + 1) * STR + srow * 2) = (bf16_t)(vw[i] >> 16); } }
        *(u32x4*)(CTs + (tid >> 3) * STR + (tid & 7) * 16) = cs0; *(u32x4*)(CTs + (64 + (tid >> 3)) * STR + (tid & 7) * 16) = cs1;
        { float sm = qv[0] * n0[0] + qv[1] * n0[1] + qv[2] * n0[2] + qv[3] * n0[3] + qv[4] * n1[0] + qv[5] * n1[1] + qv[6] * n1[2] + qv[7] * n1[3];
          sm += shx(sm, lane, 1); sm += shx(sm, lane, 2); sm += shx(sm, lane, 4);
          if (sch == 0) qn[srow] = sm; }
        if (item + G < ML_ITEMS) MLC_LOAD(item + G);
        __syncthreads();
        {
            const int t = 32 * xb + r;
            f32x16 X0, X1, Y;
#pragma unroll
            for (int i = 0; i < 16; ++i) { X0[i] = 0.f; X1[i] = 0.f; Y[i] = 0.f; }
#pragma unroll
            for (int st = 0; st < 4; ++st) {
                const bf16x8 qB = *(const bf16x8*)(Qs + t * STR + (16 * st + 8 * h) * 2);
                const bf16x8 k0 = *(const bf16x8*)(Ks + r * STR + (16 * st + 8 * h) * 2), k1 = *(const bf16x8*)(Ks + (32 + r) * STR + (16 * st + 8 * h) * 2);
                const bf16x8 cA = *(const bf16x8*)(CTs + (32 * eb + r) * STR + (16 * st + 8 * h) * 2);
                X0 = MFMA32(k0, qB, X0); X1 = MFMA32(k1, qB, X1); Y = MFMA32(cA, qB, Y);
            }
            const float Mtt = tM[t], ai = tain[t];
            float dsum = 0.f;
#pragma unroll
            for (int i = 0; i < 16; ++i) {
                const int s0 = crow(i, h), s1 = 32 + s0;
                X0[i] = (s0 <= t) ? X0[i] * __expf(tu[s0] - Mtt) : 0.f;
                X1[i] = (s1 <= t) ? X1[i] * __expf(tu[s1] - Mtt) : 0.f;
                dsum += X0[i] + X1[i]; Y[i] *= ai;
            }
            dsum += shx(dsum, lane, 32);
#pragma unroll
            for (int sb = 0; sb < 2; ++sb)
#pragma unroll
                for (int s2 = 0; s2 < 2; ++s2) {
                    const bf16x8 pf = pack8(sb ? X1 : X0, s2);
                    const char* vb = VTs + (32 * eb + r) * STR + (32 * sb + 16 * s2 + 4 * h) * 2;
                    const u32x2 lo = *(const u32x2*)vb, hi = *(const u32x2*)(vb + 16);
                    Y = MFMA32(__builtin_bit_cast(bf16x8, (u32x4){lo.x, lo.y, hi.x, hi.y}), pf, Y);
                }
            const float den = ai * qn[t] + dsum;
            const float inv = 1.f / fmaxf(fabsf(den), __expf(-(tbc[t] + Mtt)));
            bf16_t* op = HD + (size_t)ML_ROW(ci, t) * 512 + hh * 128 + 32 * eb + 4 * h;
#pragma unroll
            for (int i4 = 0; i4 < 4; ++i4) { u32x2 wv; wv.x = pk2(Y[4 * i4] * inv, Y[4 * i4 + 1] * inv); wv.y = pk2(Y[4 * i4 + 2] * inv, Y[4 * i4 + 3] * inv); *(u32x2*)(op + 8 * i4) = wv; }
        }
        __syncthreads();
    }
#undef MLC_LOAD
}

DI int mx_take(volatile int* s_item, unsigned* ctr) {
    if (threadIdx.x == 0) *s_item = (int)atomicAdd(ctr, 1u);
    __syncthreads();
    const int it = *s_item;
    __syncthreads();
    return it;
}
DI void mixer_phase(char* lds, KArgs a, int l, bool want_ctx, unsigned* ctr, unsigned char* ws, bf16_t* P, const bf16_t* Qb, const bf16_t* Qc, const bf16_t* Kb, const bf16_t* Vb, bf16_t* HD0, bf16_t* HD1) {
    volatile int* s_item = (volatile int*)(lds + 140000);
    const int x = (int)(xb_xcc_id() & 7u);
    { float Cmla, Cna; bool fix; int tx_ = threadIdx.x; asm volatile("" : "+v"(tx_)); const int lane = tx_ & 63;
      float gq = 0.f, gk = 0.f, nq = 0.f, nk = 0.f, rb = 0.f;
      for (int i = lane; i < 96; i += 64) { gq = fmaxf(gq, fabsf(a->in[17][l * 96 + i])); gk = fmaxf(gk, fabsf(a->in[18][l * 96 + i])); }
      nq = fabsf(a->in[20][l * 64 + lane]); nk = fabsf(a->in[21][l * 64 + lane]);
      for (int i = lane; i < 8 * 465; i += 64) rb = fmaxf(rb, fabsf(a->in[22][(size_t)l * 8 * 465 + i]));
#pragma unroll
      for (int o = 32; o >= 1; o >>= 1) { gq = fmaxf(gq, shx(gq, lane, o)); gk = fmaxf(gk, shx(gk, lane, o)); nq = fmaxf(nq, shx(nq, lane, o)); nk = fmaxf(nk, shx(nk, lane, o)); rb = fmaxf(rb, shx(rb, lane, o)); }
      Cmla = 9.79796f * gq * gk * LOG2E * 1.02f + 0.05f;
      Cna = (8.f * nq * nk * 1.02f + rb) * LOG2E + 0.05f;
      fix = (Cmla < 40.f) && (Cna < 40.f) && (Cmla == Cmla) && (Cna == Cna);
      volatile float* sc_ = (volatile float*)(lds + 140048);
      if (threadIdx.x == 0) { sc_[0] = Cmla; sc_[1] = Cna; sc_[2] = fix ? 1.f : 0.f; }
      __syncthreads(); }
#define MX_CMLA (((volatile float*)(lds + 140048))[0])
#define MX_CNA (((volatile float*)(lds + 140048))[1])
#define MX_FIX ((((volatile float*)(lds + 140048))[2]) != 0.f)
    const int nq = want_ctx ? 136 : 128;
    for (int k = 0; k < 8; ++k) {
        const int q = (x + k) & 7;
        for (;;) {
            const int i = mx_take(s_item, ctr + 1 + q);
            if (i >= nq) break;
            const bool fix = MX_FIX;
            AttnP p{};
            if (i < 64 || (i >= 128 && i < 132)) {
                if (i < 64) { const int bh = q + 8 * (i >> 4), qt = i & 15, bl = bh >> 3, hh = bh & 7;
                    p.Q = Qb + ((size_t)bh * SEQ + qt * 256) * 96; p.ntiles = 68; p.O = P + (size_t)(bl * SEQ + qt * 256) * NP + PC_AMLA + hh * 64;
                    p.Kb = Kb + (size_t)bh * TALL * 96; p.Vb = Vb + (size_t)bh * TALL * 64; }
                else { const int bh = q + 8 * (i - 128), bl = bh >> 3, hh = bh & 7;
                    p.Q = Qc + (size_t)bh * CTXL * 96; p.ntiles = 4; p.O = P + (size_t)(MG_LAT + bl * CTXL) * NP + PC_AMLA + hh * 64;
                    p.Kb = Kb + (size_t)bh * TALL * 96; p.Vb = Vb + (size_t)bh * TALL * 64; }
                p.q_ld = 96; p.o_ld = NP; p.C = MX_CMLA;
                if (fix) attn_unit<0, true>(lds, p); else attn_unit<0, false>(lds, p);
            } else {
                p.q_ld = NP; p.o_ld = NP; p.C = MX_CNA;
                if (i < 128) { const int u = i - 64, bh = q + 8 * (u >> 4), rb = u & 15, bl = bh >> 3, hh = bh & 7, r0 = rb * 4;
                    p.Q = P + (size_t)(bl * SEQ + r0 * 64) * NP + PC_NAQ + hh * 64; p.O = P + (size_t)(bl * SEQ + r0 * 64) * NP + PC_NAQ + hh * 64; p.r0 = r0;
                    p.rlo = min(max(r0 - 4, 0), 56); const int rhi = min(max(r0 + 3 - 4, 0), 56) + 7; p.nb = rhi - p.rlo + 1; p.ntiles = p.nb + 4;
                    p.Kb = P + (size_t)(bl * SEQ) * NP + PC_NAK + hh * 64; p.Vb = P + (size_t)(bl * SEQ) * NP + PC_NAV + hh * 64;
                    p.Kc = P + (size_t)(MG_LAT + bl * CTXL) * NP + PC_NAK + hh * 64; p.Vc = P + (size_t)(MG_LAT + bl * CTXL) * NP + PC_NAV + hh * 64;
                    p.rpb = a->in[22] + (size_t)(l * 8 + hh) * 465; }
                else { const int bh = q + 8 * (i - 132), bl = bh >> 3, hh = bh & 7;
                    p.Q = P + (size_t)(MG_LAT + bl * CTXL) * NP + PC_NAQ + hh * 64; p.O = P + (size_t)(MG_LAT + bl * CTXL) * NP + PC_NAQ + hh * 64;
                    p.r0 = 0; p.rlo = 0; p.nb = 0; p.ntiles = 4;
                    p.Kc = P + (size_t)(MG_LAT + bl * CTXL) * NP + PC_NAK + hh * 64; p.Vc = P + (size_t)(MG_LAT + bl * CTXL) * NP + PC_NAV + hh * 64;
                    p.Kb = p.Kc; p.Vb = p.Vc; p.rpb = a->in[22] + (size_t)(l * 8 + hh) * 465; }
                if (fix) attn_unit<1, true>(lds, p); else attn_unit<1, false>(lds, p);
            }
        }
    }
    mlC_phase(lds, P, ws, HD0, HD1);
}

__global__ void __launch_bounds__(512, 2) fwd_kernel(Args a_unused) {
    KArgs a = (KArgs)__builtin_amdgcn_kernarg_segment_ptr();
    extern __shared__ __attribute__((aligned(16))) unsigned char lds_raw[];
    cg::grid_group grid = cg::this_grid();
    char* lds = (char*)lds_raw;
    LAS unsigned char* ldsl = (LAS unsigned char*)lds_raw;
    const int G = gridDim.x, bid = blockIdx.x;
    { volatile LAS unsigned* st0 = (volatile LAS unsigned*)(lds_raw + 140032); if (threadIdx.x == 0) { st0[0] = 0u; st0[1] = 0u; } }
    __syncthreads();
    const XcdBarrier xbar = xcd_barrier_post((unsigned*)(a->ws + WS_CTL) + 4096, (volatile LAS unsigned*)(lds_raw + 140032));
#define GSYNC() xcd_barrier(xbar)
    unsigned char* ws = a->ws;
#define mod ((float*)(ws + WS_MOD))
#define xctx ((float*)(ws + WS_XCTX))
#define Hb ((bf16_t*)(ws + WS_H))
#define P ((bf16_t*)(ws + WS_P))
#define H2 ((bf16_t*)(ws + WS_H2))
#define U ((bf16_t*)(ws + WS_U))
#define Tb ((bf16_t*)(ws + WS_T))
#define Qb ((bf16_t*)(ws + WS_Q))
#define Qcb ((bf16_t*)(ws + WS_QC))
#define Kb ((bf16_t*)(ws + WS_K))
#define Vb ((bf16_t*)(ws + WS_V))
#define HD0 ((bf16_t*)(ws + WS_HD0))
#define HD1 ((bf16_t*)(ws + WS_HD1))
    if (bid < 192) mod_item(lds, a, bid);
    if (bid == 255 || (G < 256 && bid == 0)) { for (int i = threadIdx.x; i < 512; i += 512) { const int pos = i >> 3, f = i & 7; float sn, cs; sincosf((float)pos * expf(-(float)f * 0.125f * 9.210340371976184f), &sn, &cs);
        float* rt = (float*)(ws + WS_ROPE); rt[2 * i] = cs; rt[2 * i + 1] = sn; } }
    wconv_range(lds, a, bid, WT_LAYER, G);
    grid.sync();

#pragma unroll 1
    for (int l = 0; l < DEPTH; ++l) {
        asm volatile("" : "+s"(ws));
        const bool want_ctx = (l < DEPTH - 1);
#define modl (mod + (size_t)l * 9 * 6 * D)
#define wb (ws + WS_W + (size_t)l * W_LAYER)
#define xin_lat ((l == 0) ? a->in[0] : (const float*)a->out)
#define xin_ctx ((l == 0) ? a->in[2] : (const float*)xctx)
#pragma unroll 1
        for (int g = 0; g < NGROUP; ++g) {
            asm volatile("" : "+s"(ws));
            if (l == 1 && g == 0) {
                ctx_fixup(xctx, (const float*)(ws + WS_PART), mod + (size_t)NBATCH * 6 * D + 5 * D, 0, M_CTX);
                GSYNC();
            }
            norm_phase(xin_lat, xin_ctx, MG_LAT, MG, g * MG_LAT, g * MG_CTX, a->in[6] + l * D, modl, 0, D, Hb);
            GSYNC();
            if (want_ctx) { pg8::Gemm gm{Hb, D, (const bf16_t*)(wb + WO_IN), MG, NP, D}; pg8::StaticOrder S; S.init(MG, NP, G, bid);
              pg8::EpiStore E{P, NP, 0}; pg8::gemm_phase(ldsl, gm, S, E); }
            else { pg8::Gemm gm{Hb, D, (const bf16_t*)(wb + WO_IN), MG, NP, D}; pg8::CtxSkipOrder S; S.init(G, bid);
              pg8::EpiStore E{P, NP, 0}; pg8::gemm_phase(ldsl, gm, S, E); }
            if (l == 0 && bid >= 44) wconv_range(lds, a, WT_LAYER + g * (WT_LAYER / 2) + (bid - 44), WT_LAYER + (g + 1) * (WT_LAYER / 2), G - 44);
            GSYNC();
            { pg8::SplitOrder S; S.init(MG, TW, G, bid, 3); pg8::Gemm gm{P + PC_DQ, NP, (const bf16_t*)(wb + WO_UQ), MG, TW, 384, PC_DKV - PC_DQ, 0, 0};
              pg8::EpiStore E{Tb, TW, 0}; pg8::gemm_phase(ldsl, gm, S, E); }
            mlA_phase(lds, a, l, P, ws);
            GSYNC();
            prep_phase(a, l, want_ctx, P, Tb, Qb, Qcb, Kb, Vb, (const float*)(ws + WS_ROPE));
            mlB_phase(lds, ws);
            GSYNC();
            mixer_phase(lds, a, l, want_ctx, (unsigned*)(ws + WS_CTL) + (l * NGROUP + g) * 16, ws, P, Qb, Qcb, Kb, Vb, HD0, HD1);
            GSYNC();
            const int mrows = want_ctx ? MG : MG_LAT;
            mlcomb_phase(a, l, mrows, P, HD0, HD1);
            GSYNC();
            { pg8::MergeOrder S; S.init(mrows, D, G, bid);
              pg8::Gemm gm{P + PC_MLO, NP, (const bf16_t*)(wb + WO_MLWO), mrows, D, 512, PC_AMLA - PC_MLO, PC_NAQ - PC_MLO, D * 512};
              pg8::EpiMerge E{P}; pg8::gemm_phase(ldsl, gm, S, E); }
            GSYNC();
            { pg8::Gemm gm{P + PC_Z, NP, (const bf16_t*)(wb + WO_WOUT), mrows, D, D}; pg8::StaticOrder S; S.init(mrows, D, G, bid);
              pg8::EpiRes E{xin_lat, xin_ctx, a->out, xctx, modl, 2 * D, MG_LAT, g * MG_LAT, g * MG_CTX}; pg8::gemm_phase(ldsl, gm, S, E); }
            GSYNC();
        }
        const int frows = want_ctx ? M_ALL : M_LAT;
        norm_phase(a->out, xctx, M_LAT, frows, 0, 0, a->in[7] + l * D, modl, 3 * D, 4 * D, H2);
        GSYNC();
        { pg8::Gemm gm{H2, D, (const bf16_t*)(wb + WO_FF1), frows, DFF, D}; pg8::StaticOrder S; S.init(frows, DFF, G, bid);
          pg8::EpiStore E{U, DFF, 1}; pg8::gemm_phase(ldsl, gm, S, E); }
        GSYNC();
        { pg8::Gemm gm{U, DFF, (const bf16_t*)(wb + WO_FF2), M_LAT, D, DFF}; pg8::StaticOrder S; S.init(M_LAT, D, G, bid);
          pg8::EpiRes E{a->out, xctx, a->out, xctx, modl, 5 * D, M_LAT, 0, 0}; pg8::gemm_phase(ldsl, gm, S, E); }
        if (want_ctx) {
#pragma unroll 1
            for (int ks = 0; ks < 8; ++ks) {
                pg8::Gemm gm{U + (size_t)M_LAT * DFF + ks * 512, DFF, (const bf16_t*)(wb + WO_FF2) + ks * 512, M_CTX, D, 512, 0, 0, 0, DFF};
                pg8::StaticOrder S; S.init(M_CTX, D, G, (bid - 32 * ks + G) % G);
                pg8::EpiPartial E{(float*)(ws + WS_PART) + (size_t)ks * M_CTX * D}; pg8::gemm_phase(ldsl, gm, S, E);
            }
        }
        GSYNC();
    }
}

extern "C" void kernel_launch(void* const* d_in, const int* in_sizes, int n_in, void* d_out, int out_size, void* d_ws, size_t ws_size, hipStream_t stream) {
    static int grid = 0;
    if (grid == 0) {
        if (n_in != 27 || in_sizes[0] != M_LAT * D || out_size != M_LAT * D || ws_size < 512 * MiB) {
            fprintf(stderr, "kernel_launch: unexpected shapes (n_in %d, in0 %d, out %d, ws %zu); nothing launched\n", n_in, n_in > 0 ? in_sizes[0] : -1, out_size, ws_size); grid = -1; return; }
        int dev = 0, cus = 0, per_cu = 0;
        hipGetDevice(&dev); hipDeviceGetAttribute(&cus, hipDeviceAttributeMultiprocessorCount, dev);
        if (hipFuncSetAttribute((const void*)fwd_kernel, hipFuncAttributeMaxDynamicSharedMemorySize, LDS_BYTES) != hipSuccess) { fprintf(stderr, "hipFuncSetAttribute failed\n"); grid = -1; return; }
        hipOccupancyMaxActiveBlocksPerMultiprocessor(&per_cu, (const void*)fwd_kernel, 512, LDS_BYTES);
        if (per_cu < 1) { fprintf(stderr, "occupancy query says %d blocks/CU\n", per_cu); per_cu = 1; }
        (void)hipGetLastError();
        grid = cus;
    }
    if (grid < 0) return;
    (void)hipMemsetAsync((char*)d_ws + WS_CTL, 0, 65536, stream);
    Args a{};
    for (int i = 0; i < 27; ++i) a.in[i] = (const float*)d_in[i];
    a.out = (float*)d_out; a.ws = (unsigned char*)d_ws;
    void* args[] = {&a};
    hipError_t e = hipLaunchCooperativeKernel((const void*)fwd_kernel, dim3(grid), dim3(512), args, LDS_BYTES, stream);
    if (e != hipSuccess) fprintf(stderr, "cooperative launch failed: %s (grid %d)\n", hipGetErrorString(e), grid);
}
```
